# Optimizing an MI355X kernel written in HIP

```python
import math
import jax, jax.numpy as jnp
from jax import lax
import numpy as np


D_MODEL = 2048
BATCH = 4
SEQ = 8192
DEPTH = 2

META = 16
CHUNK = 128
PAD = CHUNK - META
QBLK = 128
NEG = -1e30
EPS = 1e-6
MIX_WIDTH = D_MODEL // 2

SSD_HEAD_DIM = 64
SSD_INNER = MIX_WIDTH
SSD_HEADS = SSD_INNER // SSD_HEAD_DIM
SSD_GROUPS = 2
SSD_STATE = 128
CONV_W = 4
SSD_CONV_CH = SSD_INNER + 2 * SSD_GROUPS * SSD_STATE

ML_HEADS = 4
ML_V = MIX_WIDTH // ML_HEADS
ML_QK = ML_V // 2
ML_WIDTH = ML_HEADS * ML_V

DA_HEADS = 8
DA_V = MIX_WIDTH // DA_HEADS
DA_QK = DA_V // 2
DA_WIDTH = DA_HEADS * DA_V
ROT_DIM = DA_QK // 4
ROPE_THETA = 500000.0

PEER_HEADS = 8
PEER_TOPK = 16
N_KEYS = 128
N_EXPERTS = N_KEYS * N_KEYS
PK_HALF = 128
PEER_BLOCK = 128

IN_SIZES = (SSD_INNER, SSD_CONV_CH, SSD_HEADS,
            ML_HEADS * ML_QK, ML_HEADS * ML_QK, ML_WIDTH, ML_HEADS, ML_HEADS, ML_WIDTH,
            DA_HEADS * 2 * DA_QK, DA_HEADS * 2 * DA_QK, DA_WIDTH,
            3 * D_MODEL)
N_IN = sum(IN_SIZES)

kernel_name = 'hybrid_ssd_mlstm_diffattn_peer'


def rms_norm(x, w):
    xf = x.astype(jnp.float32)
    y = xf * lax.rsqrt(jnp.mean(xf * xf, axis=-1, keepdims=True) + EPS)
    return (y * w.astype(jnp.float32)).astype(x.dtype)


def pad_front(t, value=0.0):
    widths = [(0, 0), (PAD, 0)] + [(0, 0)] * (t.ndim - 2)
    return jnp.pad(t, widths, constant_values=value)


def rope_tables(pos):
    inv_freq = ROPE_THETA ** (-jnp.arange(0, ROT_DIM, 2, dtype=jnp.float32) / ROT_DIM)
    ang = pos.astype(jnp.float32)[..., None] * inv_freq
    return jnp.cos(ang), jnp.sin(ang)


def apply_partial_rope(t, cos, sin):
    tf = t.astype(jnp.float32)
    c = cos[:, :, None, None, :]
    s = sin[:, :, None, None, :]
    t1 = tf[..., :ROT_DIM // 2]
    t2 = tf[..., ROT_DIM // 2:ROT_DIM]
    out = jnp.concatenate([t1 * c - t2 * s, t2 * c + t1 * s, tf[..., ROT_DIM:]], axis=-1)
    return out.astype(t.dtype)


def causal_depthwise_conv(x, w, bias):
    y = lax.conv_general_dilated(x, w[:, None, :].astype(x.dtype), window_strides=(1,),
                                 padding=[(CONV_W - 1, 0)],
                                 dimension_numbers=('NWC', 'WIO', 'NWC'),
                                 feature_group_count=x.shape[-1])
    return y + bias.astype(x.dtype)


def ssd_chunked(x, log_a, bmat, cmat):
    b, lp, nh, p = x.shape
    g, n = bmat.shape[2], bmat.shape[3]
    e = nh // g
    c = lp // CHUNK
    x = x.reshape(b, c, CHUNK, g, e, p)
    bmat = bmat.reshape(b, c, CHUNK, g, n)
    cmat = cmat.reshape(b, c, CHUNK, g, n)
    a_cs = jnp.cumsum(log_a.reshape(b, c, CHUNK, g, e).transpose(0, 3, 4, 1, 2), axis=-1)
    causal = jnp.tril(jnp.ones((CHUNK, CHUNK), dtype=bool))
    decay = jnp.exp(jnp.where(causal, a_cs[..., :, None] - a_cs[..., None, :], -jnp.inf))
    cb = jnp.einsum('bclgn,bcsgn->bgcls', cmat, bmat)
    y_diag = jnp.einsum('bgecls,bcsgep->bclgep', cb[:, :, None] * decay, x)
    to_end = jnp.exp(a_cs[..., -1:] - a_cs)
    states = jnp.einsum('bclgn,bgecl,bclgep->cbgepn', bmat, to_end, x)
    chunk_decay = jnp.exp(a_cs[..., -1]).transpose(3, 0, 1, 2)

    def step(carry, inp):
        st, dec = inp
        return carry * dec[..., None, None] + st, carry

    init = jnp.zeros(states.shape[1:], states.dtype)
    _, prev = lax.scan(step, init, (states, chunk_decay))
    y_off = jnp.einsum('bclgn,cbgepn,bgecl->bclgep', cmat, prev, jnp.exp(a_cs))
    return (y_diag + y_off).reshape(b, lp, nh, p)


def mlstm_chunked(q, k, v, i_pre, log_f):
    b, lp, h, dk = q.shape
    dv = v.shape[-1]
    c = lp // CHUNK
    q = q.reshape(b, c, CHUNK, h, dk)
    k = k.reshape(b, c, CHUNK, h, dk)
    v = v.reshape(b, c, CHUNK, h, dv)
    i_pre = i_pre.reshape(b, c, CHUNK, h).transpose(0, 3, 1, 2)
    log_f = log_f.reshape(b, c, CHUNK, h).transpose(0, 3, 1, 2)
    f_cs = jnp.cumsum(log_f, axis=-1)
    f_tot = f_cs[..., -1]
    causal = jnp.tril(jnp.ones((CHUNK, CHUNK), dtype=bool))
    log_d = jnp.where(causal, f_cs[..., :, None] - f_cs[..., None, :] + i_pre[..., None, :], -jnp.inf)
    log_w = f_tot[..., None] - f_cs + i_pre
    m_loc = jnp.max(log_w, axis=-1)
    w = jnp.exp(log_w - m_loc[..., None])
    c_loc = jnp.einsum('bhcs,bcshv,bcshk->cbhvk', w, v, k)
    n_loc = jnp.einsum('bhcs,bcshk->cbhk', w, k)

    def step(carry, inp):
        c_prev, n_prev, m_prev = carry
        c_l, n_l, m_l, f_t = inp
        m_new = jnp.maximum(f_t + m_prev, m_l)
        s_prev = jnp.exp(f_t + m_prev - m_new)
        s_loc = jnp.exp(m_l - m_new)
        c_new = s_prev[..., None, None] * c_prev + s_loc[..., None, None] * c_l
        n_new = s_prev[..., None] * n_prev + s_loc[..., None] * n_l
        return (c_new, n_new, m_new), (c_prev, n_prev, m_prev)

    init = (jnp.zeros(c_loc.shape[1:], c_loc.dtype), jnp.zeros(n_loc.shape[1:], n_loc.dtype),
            jnp.full((b, h), NEG, jnp.float32))
    _, (c_prev, n_prev, m_prev) = lax.scan(
        step, init, (c_loc, n_loc, m_loc.transpose(2, 0, 1), f_tot.transpose(2, 0, 1)))
    log_inter = f_cs + m_prev.transpose(1, 2, 0)[..., None]
    m_t = jnp.maximum(jnp.max(log_d, axis=-1), log_inter)
    s = jnp.einsum('bclhk,bcshk->bhcls', q, k) * jnp.exp(log_d - m_t[..., None])
    inter = jnp.exp(log_inter - m_t)
    num = (jnp.einsum('bhcls,bcshv->bclhv', s, v)
           + jnp.einsum('bclhk,cbhvk->bclhv', q, c_prev) * inter.transpose(0, 2, 3, 1)[..., None])
    den = jnp.sum(s, axis=-1) + jnp.einsum('bclhk,cbhk->bhcl', q, n_prev) * inter
    den = jnp.maximum(jnp.abs(den), jnp.exp(-m_t)).transpose(0, 2, 3, 1)
    return (num / den[..., None]).reshape(b, lp, h, dv)


def diff_attention(q, k, v, lam):
    b, lp, h, _, dk = q.shape
    nblk = lp // QBLK
    q_blocks = q.reshape(b, nblk, QBLK, h, 2, dk).swapaxes(0, 1)
    key_pos = jnp.arange(lp)
    scale = dk ** -0.5

    def one_block(args):
        q_blk, blk = args
        q_pos = blk * QBLK + jnp.arange(QBLK)
        s = jnp.einsum('bqhmd,bkhmd->bhmqk', q_blk, k).astype(jnp.float32) * scale
        allowed = (key_pos[None, :] <= q_pos[:, None]) & (key_pos[None, :] >= PAD)
        p = jax.nn.softmax(jnp.where(allowed, s, NEG), axis=-1)
        a = p[:, :, 0] - lam * p[:, :, 1]
        return jnp.einsum('bhqk,bkhd->bqhd', a.astype(v.dtype), v)

    o = lax.map(one_block, (q_blocks, jnp.arange(nblk)))
    return o.swapaxes(0, 1).reshape(b, lp, h, -1)


def hybrid_mixer(h, cos, sin, lam_init, w_in, conv_w, conv_b, dt_bias, a_log, d_skip, ssd_norm_w,
                 i_bias, f_bias, ml_norm_w, lq1, lk1, lq2, lk2, diff_norm_w,
                 w_bs, w_bm, w_bd, w_out):
    b, L, _ = h.shape
    f32 = jnp.float32
    proj = h @ w_in
    (z, xbc, dt_raw, mq, mk, mv, mi, mf, mo, aq, ak, av, gates) = jnp.split(
        proj, np.cumsum(IN_SIZES)[:-1].tolist(), axis=-1)

    xbc = jax.nn.silu(causal_depthwise_conv(xbc, conv_w, conv_b))
    xs, bm, cm = jnp.split(xbc, [SSD_INNER, SSD_INNER + SSD_GROUPS * SSD_STATE], axis=-1)
    xs = xs.reshape(b, L, SSD_HEADS, SSD_HEAD_DIM)
    bm = bm.reshape(b, L, SSD_GROUPS, SSD_STATE)
    cm = cm.reshape(b, L, SSD_GROUPS, SSD_STATE)
    dt = jax.nn.softplus(dt_raw.astype(f32) + dt_bias.astype(f32))
    log_a = dt * -jnp.exp(a_log.astype(f32))
    y = ssd_chunked(pad_front(xs * dt[..., None]), pad_front(log_a), pad_front(bm), pad_front(cm))[:, PAD:]
    y = y + d_skip.astype(f32)[:, None] * xs
    y_ssd = rms_norm(y.reshape(b, L, SSD_INNER) * jax.nn.silu(z.astype(f32)), ssd_norm_w).astype(h.dtype)

    q = mq.reshape(b, L, ML_HEADS, ML_QK)
    k = mk.reshape(b, L, ML_HEADS, ML_QK) * ML_QK ** -0.5
    v = mv.reshape(b, L, ML_HEADS, ML_V)
    i_pre = mi.astype(f32) + i_bias.astype(f32)
    log_f = jax.nn.log_sigmoid(mf.astype(f32) + f_bias.astype(f32))
    ht = mlstm_chunked(pad_front(q), pad_front(k), pad_front(v), pad_front(i_pre, NEG), pad_front(log_f))[:, PAD:]
    ht = rms_norm(ht, ml_norm_w.reshape(ML_HEADS, ML_V))
    y_ml = (jax.nn.sigmoid(mo.astype(f32)) * ht.reshape(b, L, ML_WIDTH)).astype(h.dtype)

    qa = apply_partial_rope(aq.reshape(b, L, DA_HEADS, 2, DA_QK), cos, sin)
    ka = apply_partial_rope(ak.reshape(b, L, DA_HEADS, 2, DA_QK), cos, sin)
    va = av.reshape(b, L, DA_HEADS, DA_V)
    lam = (jnp.exp(jnp.sum(lq1.astype(f32) * lk1.astype(f32)))
           - jnp.exp(jnp.sum(lq2.astype(f32) * lk2.astype(f32))) + lam_init)
    o = diff_attention(pad_front(qa), pad_front(ka), pad_front(va), lam)[:, PAD:]
    y_da = (rms_norm(o, diff_norm_w) * (1.0 - lam_init)).reshape(b, L, DA_WIDTH).astype(h.dtype)

    g_s, g_m, g_d = jnp.split(jax.nn.sigmoid(gates), 3, axis=-1)
    merged = g_s * (y_ssd @ w_bs) + g_m * (y_ml @ w_bm) + g_d * (y_da @ w_bd)
    return merged @ w_out


def peer_ffn(h, w_q, sub_keys, u_tab, v_tab):
    b, L, d = h.shape
    q = (h @ w_q).reshape(b, L, PEER_HEADS, 2, PK_HALF)
    s = jnp.einsum('blhmd,mhnd->blhmn', q, sub_keys).astype(jnp.float32)
    top_s, top_i = lax.top_k(s, PEER_TOPK)
    cand_s = (top_s[..., 0, :, None] + top_s[..., 1, None, :]).reshape(b, L, PEER_HEADS, PEER_TOPK * PEER_TOPK)
    cand_i = (top_i[..., 0, :, None] * N_KEYS + top_i[..., 1, None, :]).reshape(b, L, PEER_HEADS, PEER_TOPK * PEER_TOPK)
    best_s, best_pos = lax.top_k(cand_s, PEER_TOPK)
    idx = jnp.take_along_axis(cand_i, best_pos, axis=-1)
    gate = jax.nn.softmax(best_s, axis=-1).astype(h.dtype)
    n_tok = b * L
    n_pad = (-n_tok) % PEER_BLOCK
    nb = (n_tok + n_pad) // PEER_BLOCK
    hk = PEER_HEADS * PEER_TOPK
    h_f = jnp.pad(h.reshape(n_tok, d), ((0, n_pad), (0, 0))).reshape(nb, PEER_BLOCK, d)
    i_f = jnp.pad(idx.reshape(n_tok, hk), ((0, n_pad), (0, 0))).reshape(nb, PEER_BLOCK, hk)
    g_f = jnp.pad(gate.reshape(n_tok, hk), ((0, n_pad), (0, 0))).reshape(nb, PEER_BLOCK, hk)

    def one_block(args):
        hb, ib, gb = args
        act = jax.nn.gelu(jnp.einsum('td,tkd->tk', hb, u_tab[ib]), approximate=False)
        return jnp.einsum('tk,tkd->td', gb * act, v_tab[ib])

    y = lax.map(one_block, (h_f, i_f, g_f)).reshape(nb * PEER_BLOCK, d)[:n_tok]
    return y.reshape(b, L, d).astype(h.dtype)


def setup_inputs(seed: int = 0) -> dict:
    key = jax.random.key(seed)
    ks = iter(jax.random.split(key, 40))

    def nrm(shape, scale):
        return jax.random.normal(next(ks), shape, jnp.float32) * scale

    def gain(shape):
        return 1.0 + nrm(shape, 0.02)

    x = nrm((BATCH, SEQ, D_MODEL), 1.0)
    offsets = jax.random.randint(next(ks), (BATCH, 1), 0, 4096, dtype=jnp.int32)
    positions = offsets + jnp.arange(SEQ, dtype=jnp.int32)[None, :]
    meta_tokens = nrm((META, D_MODEL), 1.0)
    mix_norm_w = gain((DEPTH, D_MODEL))
    w_in = nrm((DEPTH, D_MODEL, N_IN), D_MODEL ** -0.5)
    ssd_conv_w = nrm((DEPTH, CONV_W, SSD_CONV_CH), CONV_W ** -0.5)
    ssd_conv_b = nrm((DEPTH, SSD_CONV_CH), 0.02)
    dt0 = jnp.exp(jax.random.uniform(next(ks), (DEPTH, SSD_HEADS), jnp.float32, math.log(1e-3), math.log(1e-1)))
    ssd_dt_bias = dt0 + jnp.log(-jnp.expm1(-dt0))
    ssd_a_log = jnp.log(jax.random.uniform(next(ks), (DEPTH, SSD_HEADS), jnp.float32, 1.0, 16.0))
    ssd_d = 1.0 + nrm((DEPTH, SSD_HEADS), 0.1)
    ssd_norm_w = gain((DEPTH, SSD_INNER))
    mlstm_i_bias = nrm((DEPTH, ML_HEADS), 0.1)
    mlstm_f_bias = 3.0 + jax.random.uniform(next(ks), (DEPTH, ML_HEADS), jnp.float32, 0.0, 3.0)
    mlstm_norm_w = gain((DEPTH, ML_WIDTH))
    diff_lambda_q1 = nrm((DEPTH, DA_QK), 0.1)
    diff_lambda_k1 = nrm((DEPTH, DA_QK), 0.1)
    diff_lambda_q2 = nrm((DEPTH, DA_QK), 0.1)
    diff_lambda_k2 = nrm((DEPTH, DA_QK), 0.1)
    diff_norm_w = gain((DEPTH, DA_V))
    w_branch_ssd = nrm((DEPTH, SSD_INNER, D_MODEL), SSD_INNER ** -0.5)
    w_branch_mlstm = nrm((DEPTH, ML_WIDTH, D_MODEL), ML_WIDTH ** -0.5)
    w_branch_diff = nrm((DEPTH, DA_WIDTH, D_MODEL), DA_WIDTH ** -0.5)
    w_out = nrm((DEPTH, D_MODEL, D_MODEL), D_MODEL ** -0.5)
    ffn_norm_w = gain((DEPTH, D_MODEL))
    peer_w_q = nrm((DEPTH, D_MODEL, PEER_HEADS * 2 * PK_HALF), D_MODEL ** -0.5)
    peer_sub_keys = nrm((DEPTH, 2, PEER_HEADS, N_KEYS, PK_HALF), PK_HALF ** -0.5)
    peer_u = nrm((DEPTH, N_EXPERTS, D_MODEL), D_MODEL ** -0.5)
    peer_v = nrm((DEPTH, N_EXPERTS, D_MODEL), (PEER_HEADS * PEER_TOPK) ** -0.5)
    final_norm_w = gain((D_MODEL,))
    return {'x': x, 'positions': positions, 'meta_tokens': meta_tokens, 'mix_norm_w': mix_norm_w,
            'w_in': w_in, 'ssd_conv_w': ssd_conv_w, 'ssd_conv_b': ssd_conv_b, 'ssd_dt_bias': ssd_dt_bias,
            'ssd_a_log': ssd_a_log, 'ssd_d': ssd_d, 'ssd_norm_w': ssd_norm_w,
            'mlstm_i_bias': mlstm_i_bias, 'mlstm_f_bias': mlstm_f_bias, 'mlstm_norm_w': mlstm_norm_w,
            'diff_lambda_q1': diff_lambda_q1, 'diff_lambda_k1': diff_lambda_k1,
            'diff_lambda_q2': diff_lambda_q2, 'diff_lambda_k2': diff_lambda_k2, 'diff_norm_w': diff_norm_w,
            'w_branch_ssd': w_branch_ssd, 'w_branch_mlstm': w_branch_mlstm, 'w_branch_diff': w_branch_diff,
            'w_out': w_out, 'ffn_norm_w': ffn_norm_w, 'peer_w_q': peer_w_q, 'peer_sub_keys': peer_sub_keys,
            'peer_u': peer_u, 'peer_v': peer_v, 'final_norm_w': final_norm_w}


def reference(x, positions, meta_tokens, mix_norm_w, w_in, ssd_conv_w, ssd_conv_b, ssd_dt_bias,
              ssd_a_log, ssd_d, ssd_norm_w, mlstm_i_bias, mlstm_f_bias, mlstm_norm_w,
              diff_lambda_q1, diff_lambda_k1, diff_lambda_q2, diff_lambda_k2, diff_norm_w,
              w_branch_ssd, w_branch_mlstm, w_branch_diff, w_out, ffn_norm_w, peer_w_q,
              peer_sub_keys, peer_u, peer_v, final_norm_w):
    b = x.shape[0]
    h = jnp.concatenate([jnp.broadcast_to(meta_tokens.astype(x.dtype)[None], (b, META, D_MODEL)), x], axis=1)
    pos = jnp.concatenate([jnp.broadcast_to(jnp.arange(META, dtype=jnp.int32)[None], (b, META)),
                           positions + META], axis=1)
    cos, sin = rope_tables(pos)
    for l in range(DEPTH):
        lam_init = 0.8 - 0.6 * math.exp(-0.3 * l)
        h = h + hybrid_mixer(rms_norm(h, mix_norm_w[l]), cos, sin, lam_init, w_in[l],
                             ssd_conv_w[l], ssd_conv_b[l], ssd_dt_bias[l], ssd_a_log[l], ssd_d[l],
                             ssd_norm_w[l], mlstm_i_bias[l], mlstm_f_bias[l], mlstm_norm_w[l],
                             diff_lambda_q1[l], diff_lambda_k1[l], diff_lambda_q2[l], diff_lambda_k2[l],
                             diff_norm_w[l], w_branch_ssd[l], w_branch_mlstm[l], w_branch_diff[l], w_out[l])
        h = h + peer_ffn(rms_norm(h, ffn_norm_w[l]), peer_w_q[l], peer_sub_keys[l], peer_u[l], peer_v[l])
    return rms_norm(h, final_norm_w)[:, META:]
```

```cpp
#include <hip/hip_runtime.h>
#include <cstdio>
#include <cstdint>

#ifndef MK_N_LAUNCHES
#define MK_N_LAUNCHES 1
#endif

constexpr int NB = 4, SEQ = 8192, DM = 2048, META = 16, PADR = 112;
constexpr int TPB = SEQ + META + PADR;
constexpr int TP = NB * TPB;
constexpr int N_IN = 14872;
constexpr int NA_COLS = 35 * 256;
constexpr int NG_COLS = 6144;
constexpr float EPS = 1e-6f;
constexpr int NEXP = 16384;
constexpr int DEPTH = 2;
constexpr float PEER_USCALE = 64.f, PEER_VSCALE = 16.f;

constexpr size_t MiB = 1u << 20;
constexpr size_t WS_CTL = 0, CTL_ZERO_BYTES = 1 * MiB;
constexpr size_t WS_ROPE = 1 * MiB;
constexpr size_t WS_HMETA = 3 * MiB + 256 * 1024;
constexpr size_t WS_RSTD = 3 * MiB + 768 * 1024;
constexpr size_t WS_SMALL = 4 * MiB;
constexpr size_t WS_SSQ = 9 * MiB;
constexpr size_t WS_SSQM = 14 * MiB;
constexpr size_t WS_WTA = 19 * MiB;
constexpr size_t WS_WTG = 54 * MiB;
constexpr size_t WS_WTB = 78 * MiB;
constexpr size_t WS_WTO = 90 * MiB;
constexpr size_t WS_WTQ = 98 * MiB;
constexpr size_t WS_SKP = 66 * MiB;
constexpr size_t WS_PU = 106 * MiB;
constexpr size_t WS_PV = 138 * MiB;
constexpr size_t WS_U8 = 170 * MiB;
constexpr size_t WS_U = 235 * MiB;
constexpr size_t WS_Z = 365 * MiB;
constexpr size_t WS_MO = 430 * MiB;
constexpr size_t WS_AQ = 495 * MiB;
constexpr size_t WS_MV = 560 * MiB;
constexpr size_t WS_OVL = 625 * MiB;
constexpr size_t WS_XBC = WS_OVL;
constexpr size_t WS_MQ = WS_XBC + (size_t)TP * 1536 * 2;
constexpr size_t WS_MK = WS_MQ + (size_t)TP * 512 * 2;
constexpr size_t WS_AK = WS_MK + (size_t)TP * 512 * 2;
constexpr size_t WS_AV = WS_AK + (size_t)TP * 1024 * 2;
constexpr size_t WS_VT = WS_AV + (size_t)TP * 1024 * 2;
constexpr size_t WS_GATES = WS_OVL;
constexpr size_t WS_SCORES = WS_OVL;
constexpr size_t WS_Y = WS_Z;
constexpr size_t WS_PK = WS_OVL;
constexpr size_t WS_H8 = WS_AQ;
constexpr size_t WS_QP = WS_Z;
constexpr size_t WS_IDX = WS_OVL + 390 * MiB;
constexpr size_t WS_GATE = WS_IDX + (size_t)TP * 128 * 4;
constexpr size_t WS_XCB = WS_VT + (size_t)TP * 1024 * 2;
constexpr size_t WS_XCX = WS_GATE + (size_t)TP * 128 * 4;
constexpr size_t WS_END = WS_XCX + (size_t)TP * 1024 * 2;
static_assert(WS_XCB + (size_t)TP * 512 * 2 <= WS_OVL + 390 * MiB, "overlay");
static_assert(WS_END <= 1168891328ull, "workspace budget (sum of the inputs)");

constexpr int CW_TMO = 0;
constexpr int CW_BAR = 4096;
constexpr int CW_QUEUE = 8192;

constexpr int LDS_BYTES = 163840;
constexpr int LDSCTL_OFF = LDS_BYTES - 512, MISC_OFF = LDSCTL_OFF + 64;
constexpr int NWAVES = 8;

#define GAS __attribute__((address_space(1)))
#define LAS __attribute__((address_space(3)))
typedef unsigned short bf16;
typedef unsigned v4u __attribute__((ext_vector_type(4)));
typedef unsigned v2u __attribute__((ext_vector_type(2)));
typedef float f32x4 __attribute__((ext_vector_type(4)));
typedef float f32x16 __attribute__((ext_vector_type(16)));
typedef short bf16x8 __attribute__((ext_vector_type(8)));
typedef GAS unsigned gu32;
#define RLX_AGENT __ATOMIC_RELAXED, __HIP_MEMORY_SCOPE_AGENT
#define DI __device__ __forceinline__

DI unsigned f2bf(float f) { unsigned u = __builtin_bit_cast(unsigned, f); return (u + 0x7fffu + ((u >> 16) & 1u)) >> 16; }
typedef float f32x2_t __attribute__((ext_vector_type(2))); typedef __bf16 bf16x2_t __attribute__((ext_vector_type(2)));
DI unsigned pk2(float lo, float hi) { f32x2_t v = {lo, hi}; bf16x2_t b = __builtin_convertvector(v, bf16x2_t); return __builtin_bit_cast(unsigned, b); }
DI float bflo(unsigned w) { return __builtin_bit_cast(float, w << 16); }
DI float bfhi(unsigned w) { return __builtin_bit_cast(float, w & 0xffff0000u); }
DI float wave_sum(float v) {
#pragma unroll
    for (int o = 1; o < 64; o <<= 1) v += __shfl_xor(v, o);
    return v;
}
DI float sigmoidf_(float x) { return __builtin_amdgcn_rcpf(1.f + __builtin_amdgcn_exp2f(-1.4426950408889634f * x)); }
DI float siluf_(float x) { return x * sigmoidf_(x); }
DI unsigned pk4f8(float a, float b, float c, float d) { int pk = __builtin_amdgcn_cvt_pk_fp8_f32(a, b, 0, false); pk = __builtin_amdgcn_cvt_pk_fp8_f32(c, d, pk, true); return (unsigned)pk; }
typedef __bf16 bf16x32v __attribute__((ext_vector_type(32)));
typedef unsigned u32x6v __attribute__((ext_vector_type(6)));
DI unsigned fp6enc(float x) {
    const unsigned ux = __builtin_bit_cast(unsigned, x);
    const float a = fminf(__builtin_fabsf(x), 7.5f);
    unsigned u = __builtin_bit_cast(unsigned, a); u += 0x7FFFFu + ((u >> 20) & 1u);
    const unsigned cn = (u >> 20) - (126u << 3);
    const unsigned cs = (unsigned)__builtin_rintf(a * 8.f);
    return ((ux >> 31) << 5) | (a < 1.f ? cs : cn);
}
constexpr float PEER_HS = 8.f, PEER_LO = 32.f;
constexpr float G8_ASCALE = 16.f, G8_BSCALE = 1024.f;

namespace pg8 {
#define PG8_LAS __attribute__((address_space(3)))
typedef unsigned short bf16_t;
typedef short bf16x8 __attribute__((ext_vector_type(8)));
typedef float f32x4 __attribute__((ext_vector_type(4)));
typedef unsigned u32x4 __attribute__((ext_vector_type(4)));
typedef int i32x4 __attribute__((ext_vector_type(4)));
constexpr int BM = 256, BK = 64, HALF = 128, HTB = HALF * BK * 2, STAGE_BYTES = 8 * HTB, NXCD = 8, WGM = 6;

__host__ __device__ __forceinline__ int lds_byte(int r, int c) { const int st = (r >> 4) * 2 + (c >> 5), rr = r & 15, cc = c & 31, ob = rr * 64 + cc * 2; return st * 1024 + (ob ^ (((ob >> 9) & 1) << 5)); }
__host__ __device__ __forceinline__ void stage_rc(int b, int& R, int& C) { const int st = b / 1024, sb = b % 1024, swz = sb ^ (((sb >> 9) & 1) << 5); R = (st >> 1) * 16 + swz / 64; C = (st & 1) * 32 + (swz % 64) / 2; }
__host__ __device__ __forceinline__ int perm32(int rho) { const int n = rho >> 4, i = rho & 15; return 8 * (i >> 2) + 4 * n + (i & 3); }

struct Unit { int pm, pn; };
struct Gemm { const bf16_t* A; const bf16_t* Bt; int M, N, K, lda, ldb, akoff; };

struct StaticOrder {
    int nM, nN, nwg, G, c;
    __host__ __device__ void init(int M, int N, int G_, int c_) { nM = M / BM; nN = N / BM; nwg = nM * nN; G = G_; c = c_; }
    __host__ __device__ bool next(int i, Unit& u) const {
        const long L = (long)i * G + c; if (L >= nwg) return false;
        int wgid = (int)L; { const int q = nwg / NXCD, r = nwg % NXCD, xcd = wgid % NXCD, off = wgid / NXCD; wgid = (xcd < r ? xcd * (q + 1) : r * (q + 1) + (xcd - r) * q) + off; }
        const int nig = WGM * nN, gid = wgid / nig, fm = gid * WGM, gsz = (nM - fm) < WGM ? (nM - fm) : WGM;
        u.pm = fm + ((wgid % nig) % gsz); u.pn = (wgid % nig) / gsz; return true;
    }
};

__device__ __forceinline__ unsigned cvt_pk_bf16(float lo, float hi) { unsigned r; asm volatile("v_cvt_pk_bf16_f32 %0, %1, %2" : "=v"(r) : "v"(lo), "v"(hi)); return r; }

template <class Epi, class Sched, bool F8 = false>
__device__ __forceinline__ void gemm_phase(PG8_LAS unsigned char* lds, const Gemm g, const Sched& S, const Epi& E) {
    int tid_l = threadIdx.x; asm volatile("" : "+v"(tid_l));
    const int tid = tid_l, wid = __builtin_amdgcn_readfirstlane(tid >> 6), lane = tid & 63, wr = wid >> 2, wc = wid & 3, fr = lane & 15, fq = lane >> 4;
    constexpr int ES = F8 ? 1 : 2;
    const int K = g.K, nt = K * ES / (BK * 2);
    unsigned voffA[2], voffB[2];
#pragma unroll
    for (int i = 0; i < 2; ++i) { int R, C; stage_rc(tid * 16 + i * 8192, R, C); const int Rb = ((R & ~31) + perm32(R & 31));
        voffA[i] = (unsigned)(R * g.lda * ES + C * 2); voffB[i] = (unsigned)(Rb * g.ldb * ES + C * 2); }
    const size_t kstep = (size_t)(BK * 2);
    const size_t hstepA = (size_t)HALF * g.lda * ES, hstepB = (size_t)HALF * g.ldb * ES;
    const size_t tstepA = 2 * hstepA, tstepB = 2 * hstepB;
    const unsigned ldsw = (unsigned)wid * 1024u;
    const int aoff = lds_byte(wr * 64 + fr, fq * 8), boff = lds_byte(wc * 32 + fr, fq * 8);
#define PG8_SA(b, h) (((b) * 2 + (h)) * HTB)
#define PG8_SB(b, h) ((4 + (b) * 2 + (h)) * HTB)
#define PG8_STAGE(bufoff, gbase, voff) do { _Pragma("unroll") for (int _i = 0; _i < 2; ++_i) \
        __builtin_amdgcn_global_load_lds((const unsigned*)((const char*)(gbase) + (voff)[_i]), (PG8_LAS unsigned*)(lds + (bufoff) + ldsw + _i * 8192), 16, 0, 0); } while (0)
#define PG8_LDA(dst, b, h) do { _Pragma("unroll") for (int m = 0; m < 4; ++m) _Pragma("unroll") for (int k = 0; k < 2; ++k) dst[m][k] = *(const PG8_LAS bf16x8*)(lds + PG8_SA(b, h) + aoff + m * 2048 + k * 1024); } while (0)
#define PG8_LDB(dst, b, h) do { _Pragma("unroll") for (int n = 0; n < 2; ++n) _Pragma("unroll") for (int k = 0; k < 2; ++k) dst[n][k] = *(const PG8_LAS bf16x8*)(lds + PG8_SB(b, h) + boff + n * 2048 + k * 1024); } while (0)
#define PG8_CAT(x0, x1) __builtin_shufflevector(__builtin_bit_cast(i32x4, x0), __builtin_bit_cast(i32x4, x1), 0, 1, 2, 3, 4, 5, 6, 7)
#define PG8_MMA(ai, bj, At, Bt) do { __builtin_amdgcn_s_setprio(1); _Pragma("unroll") for (int m = 0; m < 4; ++m) _Pragma("unroll") for (int n = 0; n < 2; ++n) { \
        if constexpr (F8) asm volatile("v_mfma_f32_16x16x128_f8f6f4 %0, %1, %2, %0" : "+v"(acc[ai][bj][m][n]) : "v"(PG8_CAT(Bt[n][0], Bt[n][1])), "v"(PG8_CAT(At[m][0], At[m][1])));     \
        else { _Pragma("unroll") for (int k = 0; k < 2; ++k) acc[ai][bj][m][n] = __builtin_amdgcn_mfma_f32_16x16x32_bf16(Bt[n][k], At[m][k], acc[ai][bj][m][n], 0, 0, 0); } } __builtin_amdgcn_s_setprio(0); } while (0)
#define PG8_WAIT_V(n) asm volatile("s_waitcnt vmcnt(" #n ")" ::: "memory")
#define PG8_WAIT_L(n) asm volatile("s_waitcnt lgkmcnt(" #n ")" ::: "memory")
#define PG8_BAR __builtin_amdgcn_s_barrier()
#define PG8_SCHED __builtin_amdgcn_sched_barrier(0)
    Unit cur, nxt; int ui = 0;
    if (!S.next(0, cur)) return;
    f32x4 acc[2][2][4][2];
#pragma unroll
    for (int a = 0; a < 2; ++a)
#pragma unroll
        for (int b = 0; b < 2; ++b)
#pragma unroll
            for (int m = 0; m < 4; ++m)
#pragma unroll
                for (int n = 0; n < 2; ++n) acc[a][b][m][n] = (f32x4){0.f, 0.f, 0.f, 0.f};
    bf16x8 At[4][2], B0[2][2], B1[2][2];
    const char* cA = (const char*)g.A + (size_t)cur.pm * tstepA + (size_t)cur.pn * g.akoff * 2; const char* cB = (const char*)g.Bt + (size_t)cur.pn * tstepB;
    PG8_STAGE(PG8_SB(0, 0), cB, voffB); PG8_STAGE(PG8_SB(0, 1), cB + hstepB, voffB); PG8_STAGE(PG8_SA(0, 0), cA, voffA); PG8_STAGE(PG8_SA(0, 1), cA + hstepA, voffA);
    if (wr == 1) PG8_BAR;
    PG8_WAIT_V(2); PG8_BAR;
    PG8_STAGE(PG8_SB(1, 0), cB + kstep, voffB); PG8_STAGE(PG8_SA(1, 0), cA + kstep, voffA); PG8_STAGE(PG8_SB(1, 1), cB + hstepB + kstep, voffB);
    PG8_WAIT_V(6); PG8_BAR;
    for (;;) {
        const bool has_next = S.next(ui + 1, nxt);
        const char* nA = has_next ? (const char*)g.A + (size_t)nxt.pm * tstepA + (size_t)nxt.pn * g.akoff * 2 : cA; const char* nB = has_next ? (const char*)g.Bt + (size_t)nxt.pn * tstepB : cB;
#pragma unroll 1
        for (int t = 0; t < nt; t += 2) {
            const bool last = (t == nt - 2);
            const char* a1 = cA + (size_t)(t + 1) * kstep;
            const char* a2 = last ? nA : cA + (size_t)(t + 2) * kstep; const char* b2 = last ? nB : cB + (size_t)(t + 2) * kstep;
            const char* a3 = a2 + kstep; const char* b3 = b2 + kstep;
            PG8_LDB(B0, 0, 0); PG8_LDB(B1, 0, 1); PG8_SCHED; PG8_LDA(At, 0, 0); PG8_STAGE(PG8_SA(1, 1), a1 + hstepA, voffA);
            PG8_WAIT_V(8); PG8_WAIT_L(0); PG8_BAR; PG8_MMA(0, 0, At, B0); PG8_MMA(0, 1, At, B1); PG8_BAR; PG8_SCHED;
            PG8_LDA(At, 0, 1); PG8_STAGE(PG8_SB(0, 0), b2, voffB); PG8_STAGE(PG8_SB(0, 1), b2 + hstepB, voffB); PG8_STAGE(PG8_SA(0, 0), a2, voffA);
            PG8_WAIT_V(8); PG8_WAIT_L(0); PG8_BAR; PG8_MMA(1, 0, At, B0); PG8_MMA(1, 1, At, B1); PG8_BAR; PG8_SCHED;
            PG8_LDB(B0, 1, 0); PG8_LDB(B1, 1, 1); PG8_SCHED; PG8_LDA(At, 1, 0); PG8_STAGE(PG8_SA(0, 1), a2 + hstepA, voffA);
            PG8_WAIT_V(8); PG8_WAIT_L(0); PG8_BAR; PG8_MMA(0, 0, At, B0); PG8_MMA(0, 1, At, B1); PG8_BAR; PG8_SCHED;
            PG8_LDA(At, 1, 1); PG8_STAGE(PG8_SB(1, 0), b3, voffB); PG8_STAGE(PG8_SB(1, 1), b3 + hstepB, voffB); PG8_STAGE(PG8_SA(1, 0), a3, voffA);
            PG8_WAIT_V(8); PG8_WAIT_L(0); PG8_BAR; PG8_MMA(1, 0, At, B0); PG8_MMA(1, 1, At, B1); PG8_BAR; PG8_SCHED;
        }
        if (wr == 0) PG8_BAR;
        if constexpr (F8) {
#define PG8_T(a, b) "+v"(acc[a][b][0][0]), "+v"(acc[a][b][0][1]), "+v"(acc[a][b][1][0]), "+v"(acc[a][b][1][1]), "+v"(acc[a][b][2][0]), "+v"(acc[a][b][2][1]), "+v"(acc[a][b][3][0]), "+v"(acc[a][b][3][1])
            asm volatile("s_nop 7\n\ts_nop 7\n\ts_nop 7" : PG8_T(0, 0), PG8_T(0, 1));
            asm volatile("" : PG8_T(1, 0), PG8_T(1, 1));
#undef PG8_T
        }
        { int fr_ = fr, fq_ = fq; asm volatile("" : "+v"(fr_), "+v"(fq_)); E(acc, cur, wr, wc, fr_, fq_); }
        if (!has_next) break;
#pragma unroll
        for (int a = 0; a < 2; ++a)
#pragma unroll
            for (int b = 0; b < 2; ++b)
#pragma unroll
                for (int m = 0; m < 4; ++m)
#pragma unroll
                    for (int n = 0; n < 2; ++n) acc[a][b][m][n] = (f32x4){0.f, 0.f, 0.f, 0.f};
        cur = nxt; cA = nA; cB = nB; ++ui;
        if (wr == 1) PG8_BAR;
    }
    PG8_WAIT_V(0);
    PG8_BAR;
#undef PG8_SA
#undef PG8_SB
#undef PG8_STAGE
#undef PG8_LDA
#undef PG8_LDB
#undef PG8_MMA
#undef PG8_CAT
#undef PG8_WAIT_V
#undef PG8_WAIT_L
#undef PG8_BAR
#undef PG8_SCHED
}
}

#define XB_TMO      128
#define XB_XCNT(j)  (256  + 64 * (j))
#define XB_XSUB(j)  (1280 + 64 * (j))
#define XB_XGEN(j)  (2304 + 64 * (j))
#define XB_TOP      3328
#define XB_TOPGEN   3392
#define XCD_BAR_WORDS 3456
#define XB_SPIN_CAP (1u << 22)

__device__ __forceinline__ unsigned xb_ld(unsigned* p)              { return __hip_atomic_load(p, __ATOMIC_RELAXED, __HIP_MEMORY_SCOPE_AGENT); }
__device__ __forceinline__ unsigned xb_add(unsigned* p, unsigned v) { return __hip_atomic_fetch_add(p, v, __ATOMIC_RELAXED, __HIP_MEMORY_SCOPE_AGENT); }
__device__ __forceinline__ unsigned xb_xcc_id() { return (unsigned)__builtin_amdgcn_s_getreg((3 << 11) | 20) & 0xFu; }
#define XB_SPIN(cond, bar) do { unsigned _sp = 0; while (cond) { __builtin_amdgcn_s_sleep(1); \
    if ((++_sp & 255u) == 0u) { if (xb_ld(&(bar)[XB_TMO])) break; if (_sp > XB_SPIN_CAP) { atomicAdd(&(bar)[XB_TMO], 1u); break; } } } } while (0)

struct XcdBarrier { unsigned* bar; unsigned x; volatile LAS unsigned* st; };

__device__ __forceinline__ XcdBarrier xcd_barrier_post(unsigned* bar, volatile LAS unsigned* st) {
    XcdBarrier b; b.bar = bar; b.x = xb_xcc_id(); b.st = st;
    if (threadIdx.x == 0) (void)xb_add(&bar[XB_XCNT(b.x)], 1u);
    return b;
}
__device__ __forceinline__ void xcd_barrier_complete(unsigned* bar, unsigned x, unsigned& nloc, unsigned& nx) {
    const unsigned G = gridDim.x * gridDim.y * gridDim.z;
    unsigned sum, cnt, mine, sp = 0u;
    for (;;) {
        sum = 0u; cnt = 0u; mine = 0u;
#pragma unroll
        for (unsigned j = 0; j < 16; ++j) { const unsigned c = xb_ld(&bar[XB_XCNT(j)]); sum += c; cnt += (c > 0u) ? 1u : 0u; mine = (j == x) ? c : mine; }
        if (sum == G) break;
        __builtin_amdgcn_s_sleep(1);
        if ((++sp & 255u) == 0u) { if (xb_ld(&bar[XB_TMO])) break; if (sp > XB_SPIN_CAP) { atomicAdd(&bar[XB_TMO], 1u); break; } }
    }
    nloc = mine > 0u ? mine : 1u; nx = cnt > 0u ? cnt : 1u;
}
__device__ __forceinline__ void xcd_barrier(const XcdBarrier& b) {
    asm volatile("s_waitcnt vmcnt(0)" ::: "memory");
    __syncthreads();
    if (threadIdx.x == 0) {
        unsigned* bar = b.bar;
        __builtin_amdgcn_s_waitcnt(0);
        unsigned nloc = b.st[0], nx = b.st[1];
        if (nloc == 0u) { xcd_barrier_complete(bar, b.x, nloc, nx); b.st[0] = nloc; b.st[1] = nx; }
        const unsigned old = xb_add(&bar[XB_XSUB(b.x)], 1u);
        const unsigned gen = old / nloc;
        if (old + 1u == (gen + 1u) * nloc) {
            __builtin_amdgcn_fence(__ATOMIC_RELEASE, "agent");
            asm volatile("s_waitcnt vmcnt(0)" ::: "memory");
            const unsigned og = xb_add(&bar[XB_TOP], 1u);
            const unsigned tg = og / nx;
            if (og + 1u == (tg + 1u) * nx) xb_add(&bar[XB_TOPGEN], 1u);
            else XB_SPIN(xb_ld(&bar[XB_TOPGEN]) == tg, bar);
            __builtin_amdgcn_fence(__ATOMIC_ACQUIRE, "agent");
            xb_add(&bar[XB_XGEN(b.x)], 1u);
            asm volatile("s_waitcnt vmcnt(0)" ::: "memory");
        } else {
            XB_SPIN(xb_ld(&bar[XB_XGEN(b.x)]) == gen, bar);
            __builtin_amdgcn_fence(__ATOMIC_ACQUIRE, "agent");
            asm volatile("s_waitcnt vmcnt(0)" ::: "memory");
        }
    }
    __syncthreads();
}

struct Params {
    const float* x; const int* positions; const float* meta; const float* mix_norm_w; const float* w_in; const float* conv_w; const float* conv_b;
    const float* dt_bias; const float* a_log; const float* ssd_d; const float* ssd_norm_w; const float* i_bias; const float* f_bias; const float* ml_norm_w;
    const float* lq1; const float* lk1; const float* lq2; const float* lk2; const float* diff_norm_w;
    const float* w_bs; const float* w_bm; const float* w_bd; const float* w_out; const float* ffn_norm_w; const float* peer_wq; const float* sub_keys;
    const float* peer_u; const float* peer_v; const float* final_norm_w;
    float* out; unsigned char* ws;
    int ph_lo, ph_hi;
};

struct Frame {
    LAS unsigned char* lds;
    int tid, lane, wave, G, bid;
    unsigned char* ws;
    const Params& p;
};
DI Frame fresh(const Frame& F) {
    int t = threadIdx.x; asm volatile("" : "+v"(t));
    const unsigned long long wv = (unsigned long long)F.p.ws; unsigned wl = __builtin_amdgcn_readfirstlane((unsigned)wv), wh = __builtin_amdgcn_readfirstlane((unsigned)(wv >> 32));
    asm volatile("" : "+s"(wl), "+s"(wh)); unsigned char* w = (unsigned char*)(GAS unsigned char*)(((unsigned long long)wh << 32) | wl);
    return Frame{F.lds, t, t & 63, __builtin_amdgcn_readfirstlane(t >> 6), F.G, F.bid, w, F.p};
}

DI float* hrow(const Params& p, unsigned char* ws, int r) {
    const int b = r / TPB, q = r - b * TPB;
    if (q >= 128) return p.out + ((size_t)b * SEQ + (q - 128)) * DM;
    if (q >= PADR) return (float*)(ws + WS_HMETA) + (size_t)(b * META + (q - PADR)) * DM;
    return nullptr;
}

DI void ph_rope(Frame& F) {
    float* tab = (float*)(F.ws + WS_ROPE);
    const int gt = F.bid * 512 + F.tid, NT = F.G * 512;
    for (int it = gt; it < TP * 8; it += NT) {
        const int r = it >> 3, i = it & 7, b = r / TPB, q = r - b * TPB;
        float c = 1.f, s = 0.f;
        if (q >= PADR) {
            const int pos = (q >= 128) ? (F.p.positions[b * SEQ + (q - 128)] + META) : (q - PADR);
            const float invf = (float)pow(500000.0, -(double)i / 8.0);
            const float ang = (float)pos * invf;
            c = (float)cos((double)ang); s = (float)sin((double)ang);
        }
        tab[(size_t)r * 16 + i] = c; tab[(size_t)r * 16 + 8 + i] = s;
    }
}

template <class CM, bool F8 = false>
DI void transpose_item(const float* W, int K, int Nsrc, bf16* WT, const CM& cm, const float* kscale, LAS float* scr, int kb, int nb, int lane) {
    const int k0 = 64 * kb, n0 = 32 * nb;
    const int sc = cm(n0 + (lane & 31)); const float nsc = cm.scale(n0 + (lane & 31));
#pragma unroll 8
    for (int i = 0; i < 32; ++i) { const int kk = 2 * i + (lane >> 5); float v = 0.f; if (sc >= 0) v = W[(size_t)(k0 + kk) * Nsrc + sc]; if (kscale) v *= kscale[k0 + kk]; scr[kk * 33 + (lane & 31)] = v * nsc; }
    asm volatile("s_waitcnt lgkmcnt(0)" ::: "memory");
    const int c = lane & 7;
#pragma unroll
    for (int j = 0; j < 4; ++j) { const int n = (lane >> 3) + 8 * j; const LAS float* s = scr + (8 * c) * 33 + n;
        if constexpr (F8) { *(GAS v2u*)((unsigned char*)WT + (size_t)(n0 + n) * K + k0 + 8 * c) = (v2u){pk4f8(s[0 * 33] * G8_BSCALE, s[1 * 33] * G8_BSCALE, s[2 * 33] * G8_BSCALE, s[3 * 33] * G8_BSCALE), pk4f8(s[4 * 33] * G8_BSCALE, s[5 * 33] * G8_BSCALE, s[6 * 33] * G8_BSCALE, s[7 * 33] * G8_BSCALE)}; }
        else { v4u o; o.x = pk2(s[0 * 33], s[1 * 33]); o.y = pk2(s[2 * 33], s[3 * 33]); o.z = pk2(s[4 * 33], s[5 * 33]); o.w = pk2(s[6 * 33], s[7 * 33]);
        *(GAS v4u*)(WT + (size_t)(n0 + n) * K + k0 + 8 * c) = o; } }
    asm volatile("s_waitcnt lgkmcnt(0)" ::: "memory");
}
struct CmA { DI int operator()(int n) const { if (n < 2560) return n; if (n < 4608) return n + 16; if (n < 8704) return n + 24; const int w = n - 8704; if (w < 16) return 2560 + w; if (w < 20) return 4624 + (w - 16); if (w < 24) return 4628 + (w - 20); return -1; }
    DI float scale(int n) const { if (n >= 3072 && n < 3584) return 0.08838834764831845f; if (n >= 5632 && n < 6656) return 0.125f * 1.4426950408889634f; return 1.f; } };
struct CmOff { int off; DI int operator()(int n) const { return n + off; } DI float scale(int) const { return 1.f; } };

DI void ph_weights(Frame& F, int layer) {
    const Params& p = F.p;
    LAS float* scr = (LAS float*)(F.lds + F.wave * 16384);
    const int gw = F.bid * NWAVES + F.wave, NGW = F.G * NWAVES;
    const float* w_in = p.w_in + (size_t)layer * DM * N_IN;
    constexpr int I_A = (DM / 64) * (NA_COLS / 32), I_G = (DM / 64) * (NG_COLS / 32), I_B = (1024 / 64) * (DM / 32), I_O = (DM / 64) * (DM / 32);
    constexpr int NITEMS = I_A + I_G + 3 * I_B + 2 * I_O;
    bf16* WTA = (bf16*)(F.ws + WS_WTA); bf16* WTG = (bf16*)(F.ws + WS_WTG); bf16* WTB = (bf16*)(F.ws + WS_WTB); bf16* WTO = (bf16*)(F.ws + WS_WTO); bf16* WTQ = (bf16*)(F.ws + WS_WTQ);
    for (int it = gw; it < NITEMS; it += NGW) {
        int r = it;
        if (r < I_A) { transpose_item(w_in, DM, N_IN, WTA, CmA(), nullptr, scr, r / (NA_COLS / 32), r % (NA_COLS / 32), F.lane); continue; } r -= I_A;
        if (r < I_G) { transpose_item<CmOff, true>(w_in, DM, N_IN, WTG, CmOff{8728}, nullptr, scr, r / (NG_COLS / 32), r % (NG_COLS / 32), F.lane); continue; } r -= I_G;
        if (r < I_B) { transpose_item(p.w_bs + (size_t)layer * 1024 * DM, 1024, DM, WTB, CmOff{0}, p.ssd_norm_w + layer * 1024, scr, r / (DM / 32), r % (DM / 32), F.lane); continue; } r -= I_B;
        if (r < I_B) { transpose_item(p.w_bm + (size_t)layer * 1024 * DM, 1024, DM, WTB + (size_t)DM * 1024, CmOff{0}, nullptr, scr, r / (DM / 32), r % (DM / 32), F.lane); continue; } r -= I_B;
        if (r < I_B) { transpose_item(p.w_bd + (size_t)layer * 1024 * DM, 1024, DM, WTB + (size_t)2 * DM * 1024, CmOff{0}, nullptr, scr, r / (DM / 32), r % (DM / 32), F.lane); continue; } r -= I_B;
        if (r < I_O) { transpose_item(p.w_out + (size_t)layer * DM * DM, DM, DM, WTO, CmOff{0}, nullptr, scr, r / (DM / 32), r % (DM / 32), F.lane); continue; } r -= I_O;
        transpose_item(p.peer_wq + (size_t)layer * DM * DM, DM, DM, WTQ, CmOff{0}, nullptr, scr, r / (DM / 32), r % (DM / 32), F.lane);
    }
    {
        bf16* SKP = (bf16*)(F.ws + WS_SKP);
        const float* sk = p.sub_keys + (size_t)layer * 2 * 8 * 128 * 128;
        const int gt = F.bid * 512 + F.tid, NT = F.G * 512;
        for (int it = gt; it < 2048 * 256 / 8; it += NT) {
            const int n = it >> 5, k0 = (it & 31) * 8, h = n >> 8, m = (n >> 7) & 1, key = n & 127;
            v4u o = (v4u){0u, 0u, 0u, 0u};
            if ((k0 >> 7) == m) { const float* s = sk + (((size_t)m * 8 + h) * 128 + key) * 128 + (k0 & 127);
                const f32x4 a = *(const f32x4*)s, b = *(const f32x4*)(s + 4);
                o.x = pk2(a.x, a.y); o.y = pk2(a.z, a.w); o.z = pk2(b.x, b.y); o.w = pk2(b.z, b.w); }
            *(v4u*)(SKP + (size_t)n * 256 + k0) = o;
        }
    }
    {
        const float* su = p.peer_u + (size_t)layer * NEXP * DM;
        unsigned* PU = (unsigned*)(F.ws + WS_PU);
        const size_t gt = (size_t)F.bid * 512 + F.tid, NT = (size_t)F.G * 512, n32 = (size_t)NEXP * DM / 32;
        for (size_t it = gt; it < n32; it += NT) {
            const float* s_ = su + it * 32; bf16x32v bv;
#pragma unroll
            for (int j = 0; j < 8; ++j) { const f32x4 a = __builtin_nontemporal_load((const f32x4*)(s_ + 4 * j)) * PEER_USCALE;
                bv[4 * j] = (__bf16)a.x; bv[4 * j + 1] = (__bf16)a.y; bv[4 * j + 2] = (__bf16)a.z; bv[4 * j + 3] = (__bf16)a.w; }
            const u32x6v o = __builtin_amdgcn_cvt_scalef32_pk32_fp6_bf16(bv, 1.0f);
            unsigned* d = PU + it * 6; *(v2u*)d = (v2u){o[0], o[1]}; *(v2u*)(d + 2) = (v2u){o[2], o[3]}; *(v2u*)(d + 4) = (v2u){o[4], o[5]};
        }
    }
    {
        const float* sv = p.peer_v + (size_t)layer * NEXP * DM;
        v2u* VS = (v2u*)(F.ws + WS_PV);
        constexpr int TROW = 2056;
        __syncthreads();
        for (int tl = F.bid; tl < NEXP / 64; tl += F.G) {
            const int e0 = 64 * tl;
            for (int it = 0; it < 64; ++it) { const int idx = F.tid + 512 * it, row = idx >> 9, c4 = idx & 511;
                const f32x4 a = __builtin_nontemporal_load((const f32x4*)(sv + (size_t)(e0 + row) * DM + 4 * c4)) * PEER_VSCALE;
                int pk = __builtin_amdgcn_cvt_pk_fp8_f32(a.x, a.y, 0, false); pk = __builtin_amdgcn_cvt_pk_fp8_f32(a.z, a.w, pk, true);
                *(LAS unsigned*)(F.lds + row * TROW + 4 * c4) = (unsigned)pk; }
            __syncthreads();
            for (int it = 0; it < 32; ++it) { const int idx = F.tid + 512 * it, sl = idx >> 6, e = idx & 63;
                VS[(size_t)sl * NEXP + e0 + e] = *(const LAS v2u*)(F.lds + e * TROW + 8 * sl); }
            __syncthreads();
        }
    }
}

DI void ph_norm(Frame& F, const float* w, bool init_from_x, bool add_y = false, bool w8 = false, bool wx = false) {
    const Params& p = F.p;
    bf16* U = (bf16*)(F.ws + WS_U);
    const int gw = F.bid * NWAVES + F.wave, NGW = F.G * NWAVES;
    for (int r = gw; r < TP; r += NGW) {
        v4u* o = (v4u*)(U + (size_t)r * DM) + F.lane;
        v2u* o8 = (v2u*)(F.ws + WS_U8 + (size_t)r * DM) + F.lane;
        float* h = hrow(p, F.ws, r);
        if (!h) {
#pragma unroll
            for (int j = 0; j < 4; ++j) { o[64 * j] = (v4u){0u, 0u, 0u, 0u}; if (w8) o8[64 * j] = (v2u){0u, 0u}; }
            continue;
        }
        const float* src = h;
        if (init_from_x) { const int b = r / TPB, q = r - b * TPB; src = (q >= 128) ? p.x + ((size_t)b * SEQ + (q - 128)) * DM : p.meta + (size_t)(q - PADR) * DM; }
        f32x4 v[8]; float s = 0.f;
#pragma unroll
        for (int j = 0; j < 4; ++j) { v[2 * j] = *(const f32x4*)(src + 512 * j + 8 * F.lane); v[2 * j + 1] = *(const f32x4*)(src + 512 * j + 8 * F.lane + 4); }
        if (add_y) { const bf16* yr = (const bf16*)(F.ws + WS_Y) + (size_t)r * DM;
#pragma unroll
            for (int j = 0; j < 4; ++j) { const v4u t = *(const v4u*)(yr + 512 * j + 8 * F.lane); v[2 * j] = v[2 * j] + (f32x4){bflo(t.x), bfhi(t.x), bflo(t.y), bfhi(t.y)}; v[2 * j + 1] = v[2 * j + 1] + (f32x4){bflo(t.z), bfhi(t.z), bflo(t.w), bfhi(t.w)}; } }
#pragma unroll
        for (int j = 0; j < 8; ++j) s += (v[j].x * v[j].x + v[j].y * v[j].y) + (v[j].z * v[j].z + v[j].w * v[j].w);
        if (init_from_x || add_y) {
#pragma unroll
            for (int j = 0; j < 4; ++j) { *(f32x4*)(h + 512 * j + 8 * F.lane) = v[2 * j]; *(f32x4*)(h + 512 * j + 8 * F.lane + 4) = v[2 * j + 1]; }
        }
        const float rstd = rsqrtf(wave_sum(s) * (1.f / DM) + EPS);
#pragma unroll
        for (int j = 0; j < 4; ++j) {
            const f32x4 w0 = *(const f32x4*)(w + 512 * j + 8 * F.lane), w1 = *(const f32x4*)(w + 512 * j + 8 * F.lane + 4);
            const f32x4 a = v[2 * j] * rstd * w0, b = v[2 * j + 1] * rstd * w1;
            v4u q; q.x = pk2(a.x, a.y); q.y = pk2(a.z, a.w); q.z = pk2(b.x, b.y); q.w = pk2(b.z, b.w);
            o[64 * j] = q;
            if (w8) { const f32x4 a8 = a * G8_ASCALE, b8 = b * G8_ASCALE; o8[64 * j] = (v2u){pk4f8(a8.x, a8.y, a8.z, a8.w), pk4f8(b8.x, b8.y, b8.z, b8.w)}; }
            if (wx) {
                const f32x4 ah = a * PEER_HS, bh = b * PEER_HS; const unsigned h0 = pk4f8(ah.x, ah.y, ah.z, ah.w), h1 = pk4f8(bh.x, bh.y, bh.z, bh.w);
                const f32x2_t a0 = __builtin_amdgcn_cvt_pk_f32_fp8((int)h0, false), a1 = __builtin_amdgcn_cvt_pk_f32_fp8((int)h0, true), a2 = __builtin_amdgcn_cvt_pk_f32_fp8((int)h1, false), a3 = __builtin_amdgcn_cvt_pk_f32_fp8((int)h1, true);
                const unsigned l0 = pk4f8((ah.x - a0.x) * PEER_LO, (ah.y - a0.y) * PEER_LO, (ah.z - a1.x) * PEER_LO, (ah.w - a1.y) * PEER_LO), l1 = pk4f8((bh.x - a2.x) * PEER_LO, (bh.y - a2.y) * PEER_LO, (bh.z - a3.x) * PEER_LO, (bh.w - a3.y) * PEER_LO);
                unsigned char* x8 = F.ws + WS_H8 + (size_t)r * 4096 + 512 * j + 8 * F.lane; *(v2u*)x8 = (v2u){h0, h1}; *(v2u*)(x8 + 2048) = (v2u){l0, l1}; }
        }
    }
}

DI void ph_final(Frame& F) {
    const Params& p = F.p;
    const int gw = F.bid * NWAVES + F.wave, NGW = F.G * NWAVES;
    for (int r = gw; r < NB * SEQ; r += NGW) {
        float* h = p.out + (size_t)r * DM;
        const bf16* yr = (const bf16*)(F.ws + WS_Y) + ((size_t)(r / SEQ) * TPB + 128 + (r % SEQ)) * DM;
        f32x4 v[8]; float s = 0.f;
#pragma unroll
        for (int j = 0; j < 4; ++j) { const v4u t = *(const v4u*)(yr + 512 * j + 8 * F.lane); v[2 * j] = *(const f32x4*)(h + 512 * j + 8 * F.lane) + (f32x4){bflo(t.x), bfhi(t.x), bflo(t.y), bfhi(t.y)}; v[2 * j + 1] = *(const f32x4*)(h + 512 * j + 8 * F.lane + 4) + (f32x4){bflo(t.z), bfhi(t.z), bflo(t.w), bfhi(t.w)}; }
#pragma unroll
        for (int j = 0; j < 8; ++j) s += (v[j].x * v[j].x + v[j].y * v[j].y) + (v[j].z * v[j].z + v[j].w * v[j].w);
        const float rstd = rsqrtf(wave_sum(s) * (1.f / DM) + EPS);
#pragma unroll
        for (int j = 0; j < 4; ++j) {
            const f32x4 w0 = *(const f32x4*)(p.final_norm_w + 512 * j + 8 * F.lane), w1 = *(const f32x4*)(p.final_norm_w + 512 * j + 8 * F.lane + 4);
            *(f32x4*)(h + 512 * j + 8 * F.lane) = v[2 * j] * rstd * w0; *(f32x4*)(h + 512 * j + 8 * F.lane + 4) = v[2 * j + 1] * rstd * w1;
        }
    }
}

typedef pg8::Unit Unit;
#define EPI_ROWS(ai, m) (u.pm * 256 + (ai) * 128 + wr * 64 + (m) * 16 + fr)
#define EPI_COL8(bj) ((bj) * 128 + wc * 32 + 8 * fq)
DI v4u pack8(const f32x4& a, const f32x4& b) { v4u w; w.x = pk2(a.x, a.y); w.y = pk2(a.z, a.w); w.z = pk2(b.x, b.y); w.w = pk2(b.z, b.w); return w; }

struct EpiInA {
    unsigned char* ws;
    DI void operator()(const f32x4 (&acc)[2][2][4][2], const Unit& u, int wr, int wc, int fr, int fq) const {
        const int t = u.pn;
        if (t < 34) {
            size_t off; int ld, coff;
            if (t < 4) { off = WS_Z; ld = 1024; coff = t * 256; }
            else if (t < 10) { off = WS_XBC; ld = 1536; coff = (t - 4) * 256; }
            else if (t < 12) { off = WS_MQ; ld = 512; coff = (t - 10) * 256; }
            else if (t < 14) { off = WS_MK; ld = 512; coff = (t - 12) * 256; }
            else if (t < 18) { off = WS_MV; ld = 1024; coff = (t - 14) * 256; }
            else if (t < 22) { off = WS_MO; ld = 1024; coff = (t - 18) * 256; }
            else if (t < 26) { off = WS_AQ; ld = 1024; coff = (t - 22) * 256; }
            else if (t < 30) { off = WS_AK; ld = 1024; coff = (t - 26) * 256; }
            else { off = WS_AV; ld = 1024; coff = (t - 30) * 256; }
            bf16* dst = (bf16*)(ws + off) + coff;
#pragma unroll
            for (int ai = 0; ai < 2; ++ai)
#pragma unroll
                for (int m = 0; m < 4; ++m) { bf16* rowp = dst + (size_t)EPI_ROWS(ai, m) * ld;
#pragma unroll
                    for (int bj = 0; bj < 2; ++bj) *(v4u*)(rowp + EPI_COL8(bj)) = pack8(acc[ai][bj][m][0], acc[ai][bj][m][1]);
                    asm volatile("" ::: "memory"); }
        } else {
            float* SM = (float*)(ws + WS_SMALL);
            if (wc == 0 && fq < 3) {
#pragma unroll
                for (int ai = 0; ai < 2; ++ai)
#pragma unroll
                    for (int m = 0; m < 4; ++m) { float* d = SM + (size_t)EPI_ROWS(ai, m) * 32 + 8 * fq; *(f32x4*)d = acc[ai][0][m][0]; *(f32x4*)(d + 4) = acc[ai][0][m][1]; }
            }
        }
    }
};

DI unsigned pk4u8(const f32x4& v) { return (unsigned)__builtin_rintf(v.x * 255.f) | ((unsigned)__builtin_rintf(v.y * 255.f) << 8) | ((unsigned)__builtin_rintf(v.z * 255.f) << 16) | ((unsigned)__builtin_rintf(v.w * 255.f) << 24); }
struct EpiGates {
    unsigned char* G;
    static DI float sg(float x) { return __builtin_amdgcn_rcpf(1.f + __builtin_amdgcn_exp2f(x * (-1.4426950408889634f / (G8_ASCALE * G8_BSCALE)))); }
    DI void operator()(const f32x4 (&acc)[2][2][4][2], const Unit& u, int wr, int wc, int fr, int fq) const {
#pragma unroll
        for (int ai = 0; ai < 2; ++ai)
#pragma unroll
            for (int m = 0; m < 4; ++m) { unsigned char* rowp = G + (size_t)EPI_ROWS(ai, m) * NG_COLS + u.pn * 256;
#pragma unroll
                for (int bj = 0; bj < 2; ++bj) { f32x4 v0 = acc[ai][bj][m][0], v1 = acc[ai][bj][m][1];
                    v0 = (f32x4){sg(v0.x), sg(v0.y), sg(v0.z), sg(v0.w)}; v1 = (f32x4){sg(v1.x), sg(v1.y), sg(v1.z), sg(v1.w)};
                    *(v2u*)(rowp + EPI_COL8(bj)) = (v2u){pk4u8(v0), pk4u8(v1)}; } asm volatile("" ::: "memory"); }
    }
};

template <int BR> struct EpiMerge {
    const unsigned char* G; bf16* Mg; const float* ssq;
    DI void operator()(const f32x4 (&acc)[2][2][4][2], const Unit& u, int wr, int wc, int fr, int fq) const {
#pragma unroll
        for (int ai = 0; ai < 2; ++ai)
#pragma unroll
            for (int m = 0; m < 4; ++m) { const int row = EPI_ROWS(ai, m); const unsigned char* grow = G + (size_t)row * NG_COLS + BR * 2048 + u.pn * 256; bf16* mrow = Mg + (size_t)row * DM + u.pn * 256;
                float rs = 1.f / 255.f;
                if (BR == 0) rs = ssq[row] * (1.f / 255.f);
#pragma unroll
                for (int bj = 0; bj < 2; ++bj) { const int c = EPI_COL8(bj);
                    const v2u gw = *(const v2u*)(grow + c);
                    f32x4 v0 = acc[ai][bj][m][0] * rs, v1 = acc[ai][bj][m][1] * rs;
                    v0 = v0 * (f32x4){(float)(gw.x & 255u), (float)((gw.x >> 8) & 255u), (float)((gw.x >> 16) & 255u), (float)(gw.x >> 24)}; v1 = v1 * (f32x4){(float)(gw.y & 255u), (float)((gw.y >> 8) & 255u), (float)((gw.y >> 16) & 255u), (float)(gw.y >> 24)};
                    if (BR != 0) { const v4u ow = *(const v4u*)(mrow + c);
                        v0 = v0 + (f32x4){bflo(ow.x), bfhi(ow.x), bflo(ow.y), bfhi(ow.y)}; v1 = v1 + (f32x4){bflo(ow.z), bfhi(ow.z), bflo(ow.w), bfhi(ow.w)}; }
                    *(v4u*)(mrow + c) = pack8(v0, v1); } asm volatile("" ::: "memory"); }
    }
};

struct EpiResid {
    const Params& p; unsigned char* ws;
    DI void operator()(const f32x4 (&acc)[2][2][4][2], const Unit& u, int wr, int wc, int fr, int fq) const {
#pragma unroll
        for (int ai = 0; ai < 2; ++ai)
#pragma unroll
            for (int m = 0; m < 4; ++m) { float* h = hrow(p, ws, EPI_ROWS(ai, m)); if (!h) continue; h += u.pn * 256;
#pragma unroll
                for (int bj = 0; bj < 2; ++bj) { float* d = h + EPI_COL8(bj); *(f32x4*)d = *(const f32x4*)d + acc[ai][bj][m][0]; *(f32x4*)(d + 4) = *(const f32x4*)(d + 4) + acc[ai][bj][m][1]; } asm volatile("" ::: "memory"); }
    }
};

struct EpiBf16 {
    bf16* O; int ld;
    DI void operator()(const f32x4 (&acc)[2][2][4][2], const Unit& u, int wr, int wc, int fr, int fq) const {
#pragma unroll
        for (int ai = 0; ai < 2; ++ai)
#pragma unroll
            for (int m = 0; m < 4; ++m) { bf16* rowp = O + (size_t)EPI_ROWS(ai, m) * ld + u.pn * 256;
#pragma unroll
                for (int bj = 0; bj < 2; ++bj) *(v4u*)(rowp + EPI_COL8(bj)) = pack8(acc[ai][bj][m][0], acc[ai][bj][m][1]); asm volatile("" ::: "memory"); }
    }
};
struct EpiF32 {
    float* O; int ld;
    DI void operator()(const f32x4 (&acc)[2][2][4][2], const Unit& u, int wr, int wc, int fr, int fq) const {
#pragma unroll
        for (int ai = 0; ai < 2; ++ai)
#pragma unroll
            for (int m = 0; m < 4; ++m) { float* rowp = O + (size_t)EPI_ROWS(ai, m) * ld + u.pn * 256;
#pragma unroll
                for (int bj = 0; bj < 2; ++bj) { float* d = rowp + EPI_COL8(bj); *(f32x4*)d = acc[ai][bj][m][0]; *(f32x4*)(d + 4) = acc[ai][bj][m][1]; } asm volatile("" ::: "memory"); }
    }
};

DI float row16_sum(float v) {
    v += __builtin_bit_cast(float, __builtin_amdgcn_update_dpp(0, __builtin_bit_cast(int, v), 0x128, 0xf, 0xf, false));
    v += __builtin_bit_cast(float, __builtin_amdgcn_update_dpp(0, __builtin_bit_cast(int, v), 0x124, 0xf, 0xf, false));
    v += __builtin_bit_cast(float, __builtin_amdgcn_update_dpp(0, __builtin_bit_cast(int, v), 0x122, 0xf, 0xf, false));
    v += __builtin_bit_cast(float, __builtin_amdgcn_update_dpp(0, __builtin_bit_cast(int, v), 0x121, 0xf, 0xf, false));
    return v;
}
DI float softplusf_(float x) { return x > 20.f ? x : log1pf(__expf(x)); }

DI void ph_conv(Frame& F, int layer) {
    const Params& p = F.p;
    const bf16* XBC = (const bf16*)(F.ws + WS_XBC); bf16* XCX = (bf16*)(F.ws + WS_XCX); bf16* XCB = (bf16*)(F.ws + WS_XCB);
    const float* cw = p.conv_w + (size_t)layer * 4 * 1536; const float* cb = p.conv_b + (size_t)layer * 1536;
    const int gt = F.bid * 512 + F.tid, NT = F.G * 512;
    for (int it = gt; it < TP * 192; it += NT) {
        const int r = it / 192, gi = it - r * 192, ch0 = 8 * gi; const int b = r / TPB, q = r - b * TPB;
        v4u o = (v4u){0u, 0u, 0u, 0u};
        if (q >= PADR) {
            float a[8];
            { const f32x4 b0 = *(const f32x4*)(cb + ch0), b1 = *(const f32x4*)(cb + ch0 + 4); a[0] = b0.x; a[1] = b0.y; a[2] = b0.z; a[3] = b0.w; a[4] = b1.x; a[5] = b1.y; a[6] = b1.z; a[7] = b1.w; }
#pragma unroll
            for (int j = 0; j < 4; ++j) {
                const v4u x = *(const v4u*)(XBC + (size_t)(r - 3 + j) * 1536 + ch0);
                const f32x4 w0 = *(const f32x4*)(cw + j * 1536 + ch0), w1 = *(const f32x4*)(cw + j * 1536 + ch0 + 4);
                a[0] += w0.x * bflo(x.x); a[1] += w0.y * bfhi(x.x); a[2] += w0.z * bflo(x.y); a[3] += w0.w * bfhi(x.y);
                a[4] += w1.x * bflo(x.z); a[5] += w1.y * bfhi(x.z); a[6] += w1.z * bflo(x.w); a[7] += w1.w * bfhi(x.w);
            }
            o.x = pk2(siluf_(a[0]), siluf_(a[1])); o.y = pk2(siluf_(a[2]), siluf_(a[3])); o.z = pk2(siluf_(a[4]), siluf_(a[5])); o.w = pk2(siluf_(a[6]), siluf_(a[7]));
        }
        if (ch0 < 1024) *(v4u*)(XCX + (size_t)r * 1024 + ch0) = o; else *(v4u*)(XCB + (size_t)r * 512 + (ch0 - 1024)) = o;
    }
}

constexpr int DL_RS = 136;
constexpr int DL_Q = 0, DL_K = 128 * DL_RS * 2, DL_KT = 2 * DL_K, DL_VT = 3 * DL_K, DL_SB = DL_VT + 80 * DL_RS * 2, DL_SC = DL_SB + 80 * DL_RS * 2;
static_assert(DL_SC + 8 * 512 + 64 <= LDSCTL_OFF, "DLA LDS map");
#define MFMA16(a, b, c) __builtin_amdgcn_mfma_f32_16x16x32_bf16((a), (b), (c), 0, 0, 0)
DI bf16x8 dl_frag(const LAS bf16* base, int row, int k0) { return *(const LAS bf16x8*)(base + row * DL_RS + k0); }

template <bool ML>
DI void dla_unit(Frame& F, int unit, int layer) {
    const Params& p = F.p;
    constexpr int NV = ML ? 5 : 4;
    const int tid = F.tid, lane = F.lane, w = F.wave, fr = lane & 15, fq = lane >> 4;
    const int b = unit >> 4, hh = ML ? ((unit >> 2) & 3) : (unit & 15), vq = unit & 3;
    const bf16* Qg; const bf16* Kg; const bf16* Vg;
    if (ML) { Qg = (const bf16*)(F.ws + WS_MQ) + hh * 128; Kg = (const bf16*)(F.ws + WS_MK) + hh * 128; Vg = (const bf16*)(F.ws + WS_MV) + hh * 256 + vq * 64; }
    else { Qg = (const bf16*)(F.ws + WS_XCB) + 256 + (hh >> 3) * 128; Kg = (const bf16*)(F.ws + WS_XCB) + (hh >> 3) * 128; Vg = (const bf16*)(F.ws + WS_XCX) + hh * 64; }
    LAS bf16* Qs = (LAS bf16*)(F.lds + DL_Q); LAS bf16* Ks = (LAS bf16*)(F.lds + DL_K); LAS bf16* KT = (LAS bf16*)(F.lds + DL_KT); LAS bf16* Gs = KT;
    LAS bf16* VT = (LAS bf16*)(F.lds + DL_VT); LAS bf16* Sb = (LAS bf16*)(F.lds + DL_SB);
    LAS float* g_ = (LAS float*)(F.lds + DL_SC); LAS float* cs_ = g_ + 128; LAS float* rq_ = cs_ + 128; LAS float* wg_ = rq_ + 128; LAS float* in_ = wg_ + 128; LAS float* em_ = in_ + 128; LAS float* dt_ = em_ + 128; LAS float* sc_ = dt_ + 128;
    const float* SM = (const float*)(F.ws + WS_SMALL);
    float c_a, c_b, c_d;
    if (ML) { c_a = p.i_bias[layer * 4 + hh]; c_b = p.f_bias[layer * 4 + hh]; c_d = 0.f; }
    else { c_a = p.dt_bias[layer * 16 + hh]; c_b = -__expf(p.a_log[layer * 16 + hh]); c_d = p.ssd_d[layer * 16 + hh]; }
    f32x4 St[NV];
#pragma unroll
    for (int t = 0; t < NV; ++t) St[t] = (f32x4){0.f, 0.f, 0.f, 0.f};
    for (int i = tid; i < 80 * DL_RS / 8; i += 512) ((LAS v4u*)Sb)[i] = (v4u){0u, 0u, 0u, 0u};
    for (int i = tid; i < 16 * DL_RS / 8; i += 512) { const unsigned one2 = (ML && i < DL_RS / 8) ? 0x3F803F80u : 0u; ((LAS v4u*)(VT + 64 * DL_RS))[i] = (v4u){one2, one2, one2, one2}; }
    if (tid == 0) sc_[1] = -1e30f;
    v4u qreg[4], kreg[4], vreg[2];
    const int vs_ = tid & 127, vc_ = tid >> 7;
#define DL_LOAD(c) do { const size_t r0_ = (size_t)b * TPB + 128 * (c); \
        _Pragma("unroll") for (int j = 0; j < 4; ++j) { const int idx = tid + 512 * j, rr = idx >> 4, ch = idx & 15; qreg[j] = *(const v4u*)(Qg + (r0_ + rr) * 512 + 8 * ch); kreg[j] = *(const v4u*)(Kg + (r0_ + rr) * 512 + 8 * ch); } \
        _Pragma("unroll") for (int j = 0; j < 2; ++j) vreg[j] = *(const v4u*)(Vg + (r0_ + vs_) * 1024 + 8 * (vc_ + 4 * j)); } while (0)
    DL_LOAD(0);
    __syncthreads();
    for (int c = 0; c < TPB / 128; ++c) {
        const size_t row0 = (size_t)b * TPB + 128 * c;
        if (w == 0) {
            const int l0 = 2 * lane; const bool r0 = (128 * c + l0) >= PADR, r1 = (128 * c + l0 + 1) >= PADR;
            float ld0, ld1, x0 = 0.f, x1 = 0.f, d0 = 0.f, d1 = 0.f;
            if (ML) {
                const float f0 = SM[(row0 + l0) * 32 + 20 + hh] + c_b, f1 = SM[(row0 + l0 + 1) * 32 + 20 + hh] + c_b;
                ld0 = r0 ? (fminf(f0, 0.f) - log1pf(__expf(-fabsf(f0)))) : 0.f; ld1 = r1 ? (fminf(f1, 0.f) - log1pf(__expf(-fabsf(f1)))) : 0.f;
                x0 = r0 ? (SM[(row0 + l0) * 32 + 16 + hh] + c_a) : -1e30f; x1 = r1 ? (SM[(row0 + l0 + 1) * 32 + 16 + hh] + c_a) : -1e30f;
            } else {
                d0 = r0 ? softplusf_(SM[(row0 + l0) * 32 + hh] + c_a) : 0.f; d1 = r1 ? softplusf_(SM[(row0 + l0 + 1) * 32 + hh] + c_a) : 0.f;
                ld0 = d0 * c_b; ld1 = d1 * c_b;
            }
            float run = ld0 + ld1;
#pragma unroll
            for (int o = 1; o < 64; o <<= 1) { const float y = __shfl_up(run, o); if (lane >= o) run += y; }
            const float g1 = run, g0 = run - ld1, gtot = __shfl(run, 63);
            if (ML) {
                const float mprev = sc_[1];
                const float cs0 = x0 - g0, cs1 = x1 - g1;
                float pm1 = fmaxf(cs0, cs1);
#pragma unroll
                for (int o = 1; o < 64; o <<= 1) { const float y = __shfl_up(pm1, o); if (lane >= o) pm1 = fmaxf(pm1, y); }
                float pm0 = __shfl_up(pm1, 1); pm0 = (lane == 0) ? cs0 : fmaxf(pm0, cs0);
                const float M0 = fmaxf(pm0, mprev), M1 = fmaxf(pm1, mprev), Ml = __shfl(M1, 63);
                g_[l0] = g0; g_[l0 + 1] = g1; cs_[l0] = cs0; cs_[l0 + 1] = cs1; rq_[l0] = -M0; rq_[l0 + 1] = -M1;
                in_[l0] = __expf(mprev - M0); in_[l0 + 1] = __expf(mprev - M1);
                em_[l0] = r0 ? __expf(-(g0 + M0)) : 1.f; em_[l0 + 1] = r1 ? __expf(-(g1 + M1)) : 1.f;
                wg_[l0] = __expf(cs0 - Ml); wg_[l0 + 1] = __expf(cs1 - Ml);
                if (lane == 0) { sc_[0] = __expf(mprev - Ml); sc_[1] = gtot + Ml; }
            } else {
                g_[l0] = g0; g_[l0 + 1] = g1; cs_[l0] = -g0; cs_[l0 + 1] = -g1; rq_[l0] = g0; rq_[l0 + 1] = g1;
                in_[l0] = __expf(g0); in_[l0 + 1] = __expf(g1); wg_[l0] = __expf(gtot - g0); wg_[l0 + 1] = __expf(gtot - g1);
                dt_[l0] = d0; dt_[l0 + 1] = d1;
                if (lane == 0) sc_[0] = __expf(gtot);
            }
        }
        __syncthreads();
#pragma unroll
        for (int j = 0; j < 4; ++j) { const int idx = tid + 512 * j, rr = idx >> 4, ch = idx & 15; *(LAS v4u*)(Qs + rr * DL_RS + 8 * ch) = qreg[j]; *(LAS v4u*)(Ks + rr * DL_RS + 8 * ch) = kreg[j]; }
        { const float dsc = ML ? 1.f : dt_[vs_];
#pragma unroll
          for (int j = 0; j < 2; ++j) { LAS bf16* d = VT + (8 * (vc_ + 4 * j)) * DL_RS + vs_; const v4u x = vreg[j];
              d[0 * DL_RS] = (bf16)f2bf(bflo(x.x) * dsc); d[1 * DL_RS] = (bf16)f2bf(bfhi(x.x) * dsc); d[2 * DL_RS] = (bf16)f2bf(bflo(x.y) * dsc); d[3 * DL_RS] = (bf16)f2bf(bfhi(x.y) * dsc);
              d[4 * DL_RS] = (bf16)f2bf(bflo(x.z) * dsc); d[5 * DL_RS] = (bf16)f2bf(bfhi(x.z) * dsc); d[6 * DL_RS] = (bf16)f2bf(bflo(x.w) * dsc); d[7 * DL_RS] = (bf16)f2bf(bfhi(x.w) * dsc); } }
        __syncthreads();
        { const int s_ = tid & 127, cg = tid >> 7; const float ws = wg_[s_];
#pragma unroll
          for (int c4 = 0; c4 < 4; ++c4) { const int ch = 4 * cg + c4; const v4u x = *(const LAS v4u*)(Ks + s_ * DL_RS + 8 * ch); LAS bf16* d = KT + (8 * ch) * DL_RS + s_;
              d[0 * DL_RS] = (bf16)f2bf(bflo(x.x) * ws); d[1 * DL_RS] = (bf16)f2bf(bfhi(x.x) * ws); d[2 * DL_RS] = (bf16)f2bf(bflo(x.y) * ws); d[3 * DL_RS] = (bf16)f2bf(bfhi(x.y) * ws);
              d[4 * DL_RS] = (bf16)f2bf(bflo(x.z) * ws); d[5 * DL_RS] = (bf16)f2bf(bfhi(x.z) * ws); d[6 * DL_RS] = (bf16)f2bf(bflo(x.w) * ws); d[7 * DL_RS] = (bf16)f2bf(bfhi(x.w) * ws); } }
        f32x4 Y[NV];
#pragma unroll
        for (int t = 0; t < NV; ++t) Y[t] = (f32x4){0.f, 0.f, 0.f, 0.f};
#pragma unroll
        for (int ks = 0; ks < 4; ++ks) { const bf16x8 a = dl_frag(Qs, 16 * w + fr, 32 * ks + 8 * fq);
#pragma unroll
            for (int t = 0; t < NV; ++t) Y[t] = MFMA16(a, dl_frag(Sb, 16 * t + fr, 32 * ks + 8 * fq), Y[t]); }
        __syncthreads();
        { const float dec = sc_[0];
#pragma unroll
          for (int t = 0; t < NV; ++t) St[t] = St[t] * dec;
#pragma unroll
          for (int ks = 0; ks < 4; ++ks) { const bf16x8 bb = dl_frag(KT, 16 * w + fr, 32 * ks + 8 * fq);
#pragma unroll
              for (int t = 0; t < NV; ++t) St[t] = MFMA16(dl_frag(VT, 16 * t + fr, 32 * ks + 8 * fq), bb, St[t]); }
#pragma unroll
          for (int t = 0; t < NV; ++t) { LAS bf16* d = Sb + (16 * t + 4 * fq) * DL_RS + 16 * w + fr;
              d[0 * DL_RS] = (bf16)f2bf(St[t].x); d[1 * DL_RS] = (bf16)f2bf(St[t].y); d[2 * DL_RS] = (bf16)f2bf(St[t].z); d[3 * DL_RS] = (bf16)f2bf(St[t].w); } }
        if (c + 1 < TPB / 128) DL_LOAD(c + 1);
        __syncthreads();
        {
            float rq[4], inr[4];
#pragma unroll
            for (int i = 0; i < 4; ++i) { rq[i] = rq_[16 * w + 4 * fq + i]; inr[i] = in_[16 * w + 4 * fq + i]; }
#pragma unroll
            for (int ct = 0; ct < 8; ++ct) {
                if (ct <= (w | 1)) {
                    f32x4 sc = (f32x4){0.f, 0.f, 0.f, 0.f};
                    if (ct <= w) {
#pragma unroll
                        for (int ks = 0; ks < 4; ++ks) sc = MFMA16(dl_frag(Qs, 16 * w + fr, 32 * ks + 8 * fq), dl_frag(Ks, 16 * ct + fr, 32 * ks + 8 * fq), sc);
                        const float cs = cs_[16 * ct + fr]; const int scol = 16 * ct + fr;
#pragma unroll
                        for (int i = 0; i < 4; ++i) { const int lr = 16 * w + 4 * fq + i; const float wt = (scol <= lr) ? __expf(rq[i] + cs) : 0.f; sc[i] = sc[i] * wt; }
                    }
                    LAS bf16* d = Gs + (16 * w + 4 * fq) * DL_RS + 16 * ct + fr;
                    d[0 * DL_RS] = (bf16)f2bf(sc.x); d[1 * DL_RS] = (bf16)f2bf(sc.y); d[2 * DL_RS] = (bf16)f2bf(sc.z); d[3 * DL_RS] = (bf16)f2bf(sc.w);
                }
            }
#pragma unroll
            for (int t = 0; t < NV; ++t) { Y[t].x *= inr[0]; Y[t].y *= inr[1]; Y[t].z *= inr[2]; Y[t].w *= inr[3]; }
#pragma unroll
            for (int ks = 0; ks < 4; ++ks) {
                if (2 * ks <= w) { const bf16x8 a = dl_frag(Gs, 16 * w + fr, 32 * ks + 8 * fq);
#pragma unroll
                    for (int t = 0; t < NV; ++t) Y[t] = MFMA16(a, dl_frag(VT, 16 * t + fr, 32 * ks + 8 * fq), Y[t]); }
            }
        }
        if (ML) {
            bf16* MVo = (bf16*)(F.ws + WS_MV) + hh * 256 + vq * 64; float* SSQM = (float*)(F.ws + WS_SSQM);
#pragma unroll
            for (int i = 0; i < 4; ++i) { const int lr = 16 * w + 4 * fq + i; const bool real = (128 * c + lr) >= PADR;
                float dn = (fr == 0) ? Y[NV - 1][i] : 0.f; dn = row16_sum(dn);
                const float den = fmaxf(fabsf(dn), em_[lr]); const float rden = 1.f / den; float ss = 0.f;
#pragma unroll
                for (int t = 0; t < 4; ++t) { const float hv = Y[t][i] * rden; ss += hv * hv; if (real) MVo[(row0 + lr) * 1024 + 16 * t + fr] = (bf16)f2bf(hv); }
                ss = row16_sum(ss);
                if (fr == 0 && real) SSQM[(row0 + lr) * 32 + hh * 4 + vq] = ss; }
        } else {
            bf16* Zo = (bf16*)(F.ws + WS_Z) + hh * 64; const bf16* Xo = (const bf16*)(F.ws + WS_XCX) + hh * 64; float* SSQ = (float*)(F.ws + WS_SSQ);
#pragma unroll
            for (int i = 0; i < 4; ++i) { const int lr = 16 * w + 4 * fq + i; const bool real = (128 * c + lr) >= PADR; float ss = 0.f;
                if (real) {
#pragma unroll
                    for (int t = 0; t < 4; ++t) { const size_t off = (row0 + lr) * 1024 + 16 * t + fr;
                        const float xs = __builtin_bit_cast(float, (unsigned)Xo[off] << 16), zz = __builtin_bit_cast(float, (unsigned)Zo[off] << 16);
                        const float yv = (Y[t][i] + c_d * xs) * siluf_(zz); ss += yv * yv; Zo[off] = (bf16)f2bf(yv); } }
                ss = row16_sum(ss);
                if (fr == 0 && real) SSQ[(row0 + lr) * 32 + hh] = ss; }
        }
        __syncthreads();
    }
#undef DL_LOAD
}

DI void ph_mlfinal(Frame& F, int layer) {
    const Params& p = F.p;
    const bf16* MV = (const bf16*)(F.ws + WS_MV); bf16* MO = (bf16*)(F.ws + WS_MO); const float* SSQM = (const float*)(F.ws + WS_SSQM);
    const float* w = p.ml_norm_w + layer * 1024;
    const int gw = F.bid * NWAVES + F.wave, NGW = F.G * NWAVES;
    for (int r = gw; r < TP; r += NGW) {
        const int b = r / TPB, q = r - b * TPB; if (q < PADR) { if (F.lane == 0) ((float*)(F.ws + WS_RSTD))[r] = 0.f; continue; }
        { const float sp = (F.lane < 16) ? ((const float*)(F.ws + WS_SSQ))[(size_t)r * 32 + F.lane] : 0.f; const float tot = wave_sum(sp);
          if (F.lane == 0) ((float*)(F.ws + WS_RSTD))[r] = rsqrtf(tot * (1.f / 1024.f) + EPS); }
        const int hd = F.lane >> 4;
        const f32x4 s0 = *(const f32x4*)(SSQM + (size_t)r * 32 + hd * 4);
        const float rstd = rsqrtf(((s0.x + s0.y) + (s0.z + s0.w)) * (1.f / 256.f) + EPS);
#pragma unroll
        for (int j = 0; j < 2; ++j) {
            const size_t off = (size_t)r * 1024 + 16 * F.lane + 8 * j;
            const v4u hv = *(const v4u*)(MV + off), ov = *(const v4u*)(MO + off);
            const f32x4 w0 = *(const f32x4*)(w + 16 * F.lane + 8 * j), w1 = *(const f32x4*)(w + 16 * F.lane + 8 * j + 4);
            const f32x4 a = (f32x4){bflo(hv.x), bfhi(hv.x), bflo(hv.y), bfhi(hv.y)} * (f32x4){sigmoidf_(bflo(ov.x)), sigmoidf_(bfhi(ov.x)), sigmoidf_(bflo(ov.y)), sigmoidf_(bfhi(ov.y))} * w0 * rstd;
            const f32x4 c = (f32x4){bflo(hv.z), bfhi(hv.z), bflo(hv.w), bfhi(hv.w)} * (f32x4){sigmoidf_(bflo(ov.z)), sigmoidf_(bfhi(ov.z)), sigmoidf_(bflo(ov.w)), sigmoidf_(bfhi(ov.w))} * w1 * rstd;
            *(v4u*)(MO + off) = pack8(a, c);
        }
    }
}


DI void ph_rope_apply(Frame& F) {
    const Params& p = F.p;
    const float* tab = (const float*)(F.ws + WS_ROPE);
    const int gw = F.bid * NWAVES + F.wave, NGW = F.G * NWAVES, lane = F.lane;
    bf16* T = (bf16*)(F.ws + ((lane >> 5) ? WS_AK : WS_AQ));
    const int grp = (lane >> 1) & 15, half = lane & 1;
    for (int r = gw; r < TP; r += NGW) {
        const int b = r / TPB, q = r - b * TPB; if (q < PADR) continue;
        const f32x4 c = *(const f32x4*)(tab + (size_t)r * 16 + 4 * half), sn = *(const f32x4*)(tab + (size_t)r * 16 + 8 + 4 * half);
        bf16* base = T + (size_t)r * 1024 + grp * 64 + 4 * half;
        const v2u w1 = *(const v2u*)base, w2 = *(const v2u*)(base + 8);
        const f32x4 t1 = (f32x4){bflo(w1.x), bfhi(w1.x), bflo(w1.y), bfhi(w1.y)}, t2 = (f32x4){bflo(w2.x), bfhi(w2.x), bflo(w2.y), bfhi(w2.y)};
        const f32x4 o1 = t1 * c - t2 * sn, o2 = t2 * c + t1 * sn;
        v2u a, d; a.x = pk2(o1.x, o1.y); a.y = pk2(o1.z, o1.w); d.x = pk2(o2.x, o2.y); d.y = pk2(o2.z, o2.w);
        *(v2u*)base = a; *(v2u*)(base + 8) = d;
    }
}
DI void ph_vtranspose(Frame& F) {
    const Params& p = F.p;
    const bf16* AV = (const bf16*)(F.ws + WS_AV); bf16* VT = (bf16*)(F.ws + WS_VT);
    LAS bf16* tile = (LAS bf16*)F.lds;
    const int tid = F.tid;
    constexpr int NT = NB * (TPB / 64) * 8;
    for (int t = F.bid; t < NT; t += F.G) {
        const int head = t & 7, rb = (t >> 3) % (TPB / 64), b = (t >> 3) / (TPB / 64);
        { const int l = tid >> 3, c16 = tid & 7;
          const bf16* src = AV + ((size_t)b * TPB + rb * 64 + l) * 1024 + head * 128 + 16 * c16;
          const v4u x0 = *(const v4u*)src, x1 = *(const v4u*)(src + 8);
          LAS bf16* d = tile + (16 * c16) * 72 + l;
          d[0 * 72] = (bf16)(x0.x & 0xffff); d[1 * 72] = (bf16)(x0.x >> 16); d[2 * 72] = (bf16)(x0.y & 0xffff); d[3 * 72] = (bf16)(x0.y >> 16);
          d[4 * 72] = (bf16)(x0.z & 0xffff); d[5 * 72] = (bf16)(x0.z >> 16); d[6 * 72] = (bf16)(x0.w & 0xffff); d[7 * 72] = (bf16)(x0.w >> 16);
          d[8 * 72] = (bf16)(x1.x & 0xffff); d[9 * 72] = (bf16)(x1.x >> 16); d[10 * 72] = (bf16)(x1.y & 0xffff); d[11 * 72] = (bf16)(x1.y >> 16);
          d[12 * 72] = (bf16)(x1.z & 0xffff); d[13 * 72] = (bf16)(x1.z >> 16); d[14 * 72] = (bf16)(x1.w & 0xffff); d[15 * 72] = (bf16)(x1.w >> 16); }
        __syncthreads();
        { const int dv = tid >> 2, seg = tid & 3;
          const LAS bf16* sp = tile + dv * 72 + 16 * seg;
          const v4u y0 = *(const LAS v4u*)sp, y1 = *(const LAS v4u*)(sp + 8);
          bf16* dst = VT + ((size_t)(b * 8 + head) * 128 + dv) * TPB + rb * 64 + 16 * seg;
          *(v4u*)dst = y0; *(v4u*)(dst + 8) = y1; }
        __syncthreads();
    }
}

DI unsigned cvtpk_s(float lo, float hi) { return pk2(lo, hi); }
DI float max3f_(float a, float b, float c) { float r; asm("v_max3_f32 %0, %1, %2, %3" : "=v"(r) : "v"(a), "v"(b), "v"(c)); return r; }
DI int crow(int r, int hi) { return (r & 3) + 8 * (r >> 2) + 4 * hi; }
#define MFMA32(a, b, c) __builtin_amdgcn_mfma_f32_32x32x16_bf16((a), (b), (c), 0, 0, 0)
constexpr int AT_STAGE = 32768, AT_KM = 8192, AT_V = 16384;
DI void glds16(const void* gsrc, unsigned lds_dst) { unsigned keep; asm volatile("s_mov_b32 %0, m0\n\ts_mov_b32 m0, %2\n\ts_nop 0\n\tglobal_load_lds_dwordx4 %1, off\n\ts_mov_b32 m0, %0" : "=&s"(keep) : "v"(gsrc), "s"(lds_dst) : "memory"); }

DI void attn_unit(Frame& F, int b, int head, int qb, int layer) {
    const Params& p = F.p;
    const int lane = F.lane, w = F.wave, map = w >> 2, qg = w & 3, r = lane & 31, hh = lane >> 5;
    bf16* AQ = (bf16*)(F.ws + WS_AQ); const bf16* AK = (const bf16*)(F.ws + WS_AK); const bf16* VT = (const bf16*)(F.ws + WS_VT);
    const int qw0 = 128 * qb + 32 * qg;
    const size_t rowb = (size_t)b * TPB;
    bf16x8 qf[4];
    { const bf16* qp = AQ + (rowb + qw0 + r) * 1024 + head * 128 + map * 64 + 8 * hh;
#pragma unroll
        for (int s = 0; s < 4; ++s) qf[s] = *(const bf16x8*)(qp + 16 * s); }
    f32x16 O[4];
#pragma unroll
    for (int d = 0; d < 4; ++d)
#pragma unroll
        for (int i = 0; i < 16; ++i) O[d][i] = 0.f;
    float mrun = -1e30f, lrun = 0.f;
    const int tlast = 2 * qb + 1;
    const bf16* src[4]; unsigned dst[4];
    const unsigned lds0 = (unsigned)(uintptr_t)F.lds;
#pragma unroll
    for (int i = 0; i < 4; ++i) {
        const int pc = 4 * w + i, rin = lane >> 3;
        if (pc < 16) { const int km = pc >> 3, R = 8 * (pc & 7) + rin, m5 = R & 31, dc = (lane & 7) ^ ((R >> 1) & 7), key = (R & 32) + ((m5 & ~12) | ((m5 & 4) << 1) | ((m5 & 8) >> 1));
            src[i] = AK + (rowb + key) * 1024 + head * 128 + km * 64 + 8 * dc; dst[i] = lds0 + km * AT_KM + (pc & 7) * 1024; }
        else { const int R = 8 * (pc - 16) + rin, dc = (lane & 7) ^ ((R >> 1) & 7);
            src[i] = VT + ((size_t)(b * 8 + head) * 128 + R) * TPB + 8 * dc; dst[i] = lds0 + AT_V + (pc - 16) * 1024; }
    }
    const bool isk = w < 4;
#define AT_DMA(t, stg) do { const size_t go = isk ? (size_t)(t) * 64 * 1024 : (size_t)(t) * 64; \
        _Pragma("unroll") for (int i = 0; i < 4; ++i) glds16(src[i] + go, (unsigned)__builtin_amdgcn_readfirstlane(dst[i] + (stg) * AT_STAGE)); } while (0)
    const int xr = (r >> 1) & 7;
    int koff[4];
#pragma unroll
    for (int s = 0; s < 4; ++s) koff[s] = 16 * ((2 * s + hh) ^ xr);
    __syncthreads();
    AT_DMA(1, 0);
    if (tlast >= 2) AT_DMA(2, 1);
    if (tlast >= 3) AT_DMA(3, 2);
    if (tlast >= 3) asm volatile("s_waitcnt vmcnt(8) lgkmcnt(0)\n\ts_barrier" ::: "memory");
    else if (tlast == 2) asm volatile("s_waitcnt vmcnt(4) lgkmcnt(0)\n\ts_barrier" ::: "memory");
    else asm volatile("s_waitcnt vmcnt(0) lgkmcnt(0)\n\ts_barrier" ::: "memory");
#define AT_QK(SA, SB, t_) do { const LAS unsigned char* kb_ = F.lds + (((t_) - 1) & 3) * AT_STAGE + map * AT_KM + r * 128; \
        _Pragma("unroll") for (int i = 0; i < 16; ++i) { SA[i] = 0.f; SB[i] = 0.f; } \
        bf16x8 kf_[8]; _Pragma("unroll") for (int s = 0; s < 4; ++s) { kf_[2 * s] = *(const LAS bf16x8*)(kb_ + koff[s]); kf_[2 * s + 1] = *(const LAS bf16x8*)(kb_ + 32 * 128 + koff[s]); } \
        __builtin_amdgcn_sched_barrier(0); \
        _Pragma("unroll") for (int s = 0; s < 4; ++s) { SA = MFMA32(kf_[2 * s], qf[s], SA); SB = MFMA32(kf_[2 * s + 1], qf[s], SB); } \
        if (((t_) == 1) || (64 * (t_) + 63 > qw0)) { const int qp = qw0 + r, k0 = 64 * (t_) + 8 * hh; \
            _Pragma("unroll") for (int i = 0; i < 16; ++i) { const int kp = k0 + (i & 3) + 4 * ((i >> 2) & 1) + 16 * (i >> 3); if (kp > qp || kp < PADR) SA[i] = -1e30f; if (kp + 32 > qp || kp + 32 < PADR) SB[i] = -1e30f; } } } while (0)
    f32x16 S0, S1, N0, N1;
    AT_QK(S0, S1, 1);
    for (int t = 1; t <= tlast; ++t) {
        if (t < tlast) {
            if (t + 2 <= tlast) asm volatile("s_waitcnt vmcnt(4) lgkmcnt(0)\n\ts_barrier" ::: "memory");
            else asm volatile("s_waitcnt vmcnt(0) lgkmcnt(0)\n\ts_barrier" ::: "memory");
            if (t + 3 <= tlast) AT_DMA(t + 3, (t + 2) & 3);
            AT_QK(N0, N1, t + 1);
        }
        const LAS unsigned char* vbase = F.lds + ((t - 1) & 3) * AT_STAGE + AT_V + r * 128;
        float mx = max3f_(S0[0], S1[0], S0[1]), my = max3f_(S1[1], S0[2], S1[2]);
#pragma unroll
        for (int i = 3; i < 15; i += 2) { mx = max3f_(mx, S0[i], S1[i]); my = max3f_(my, S0[i + 1], S1[i + 1]); }
        mx = max3f_(mx, S0[15], S1[15]); mx = fmaxf(mx, my);
        { const auto sw = __builtin_amdgcn_permlane32_swap(__builtin_bit_cast(unsigned, mx), __builtin_bit_cast(unsigned, mx), false, false); mx = fmaxf(__builtin_bit_cast(float, sw[0]), __builtin_bit_cast(float, sw[1])); }
        if (!__all(mx <= mrun)) {
            const float mn = fmaxf(mrun, mx), alpha = __builtin_amdgcn_exp2f(mrun - mn);
            mrun = mn; lrun *= alpha;
#pragma unroll
            for (int d = 0; d < 4; ++d)
#pragma unroll
                for (int i = 0; i < 16; ++i) O[d][i] *= alpha;
        }
        f32x2_t ps2 = {0.f, 0.f};
#pragma unroll
        for (int i = 0; i < 16; ++i) { S0[i] = __builtin_amdgcn_exp2f(S0[i] - mrun); S1[i] = __builtin_amdgcn_exp2f(S1[i] - mrun); ps2 += (f32x2_t){S0[i], S1[i]}; }
        lrun += ps2.x + ps2.y;
#pragma unroll
        for (int s2 = 0; s2 < 2; ++s2) {
            v4u pw; pw.x = cvtpk_s(S0[8 * s2 + 0], S0[8 * s2 + 1]); pw.y = cvtpk_s(S0[8 * s2 + 2], S0[8 * s2 + 3]); pw.z = cvtpk_s(S0[8 * s2 + 4], S0[8 * s2 + 5]); pw.w = cvtpk_s(S0[8 * s2 + 6], S0[8 * s2 + 7]);
            const bf16x8 pf = __builtin_bit_cast(bf16x8, pw);
            bf16x8 vf[4];
#pragma unroll
            for (int d = 0; d < 4; ++d) vf[d] = *(const LAS bf16x8*)(vbase + d * 32 * 128 + koff[s2]);
#pragma unroll
            for (int d = 0; d < 4; ++d) O[d] = MFMA32(vf[d], pf, O[d]);
        }
#pragma unroll
        for (int s2 = 0; s2 < 2; ++s2) {
            v4u pw; pw.x = cvtpk_s(S1[8 * s2 + 0], S1[8 * s2 + 1]); pw.y = cvtpk_s(S1[8 * s2 + 2], S1[8 * s2 + 3]); pw.z = cvtpk_s(S1[8 * s2 + 4], S1[8 * s2 + 5]); pw.w = cvtpk_s(S1[8 * s2 + 6], S1[8 * s2 + 7]);
            const bf16x8 pf = __builtin_bit_cast(bf16x8, pw);
            bf16x8 vf[4];
#pragma unroll
            for (int d = 0; d < 4; ++d) vf[d] = *(const LAS bf16x8*)(vbase + d * 32 * 128 + koff[2 + s2]);
#pragma unroll
            for (int d = 0; d < 4; ++d) O[d] = MFMA32(vf[d], pf, O[d]);
        }
        if (t < tlast) { S0 = N0; S1 = N1; }
    }
#undef AT_QK
#undef AT_DMA
    __syncthreads();
    LAS unsigned char* lds = F.lds;
    lrun += __shfl_xor(lrun, 32);
    const float inv = 1.f / lrun;
    const float lam_init = 0.8f - 0.6f * __expf(-0.3f * (float)layer);
    float lam;
    { const float a1 = wave_sum(p.lq1[layer * 64 + lane] * p.lk1[layer * 64 + lane]), a2 = wave_sum(p.lq2[layer * 64 + lane] * p.lk2[layer * 64 + lane]);
      lam = __expf(a1) - __expf(a2) + lam_init; }
    LAS float* comb = (LAS float*)lds;
    if (map == 1) {
#pragma unroll
        for (int d = 0; d < 4; ++d)
#pragma unroll
            for (int i = 0; i < 16; ++i) comb[(qg * 128 + 32 * d + crow(i, hh)) * 32 + r] = O[d][i] * inv * lam;
    }
    __syncthreads();
    if (map == 0) {
        float ss = 0.f;
#pragma unroll
        for (int d = 0; d < 4; ++d)
#pragma unroll
            for (int i = 0; i < 16; ++i) { const float v = O[d][i] * inv - comb[(qg * 128 + 32 * d + crow(i, hh)) * 32 + r]; O[d][i] = v; ss += v * v; }
        ss += __shfl_xor(ss, 32);
        const float rs = rsqrtf(ss * (1.f / 128.f) + EPS) * (1.f - lam_init);
        const float* nw = p.diff_norm_w + layer * 128;
        if (qw0 + r >= PADR) {
            bf16* op = AQ + (rowb + qw0 + r) * 1024 + head * 128;
#pragma unroll
            for (int d = 0; d < 4; ++d)
#pragma unroll
                for (int g4 = 0; g4 < 4; ++g4) { const int dv = 32 * d + 8 * g4 + 4 * hh; const f32x4 wv = *(const f32x4*)(nw + dv);
                    v2u o; o.x = pk2(O[d][4 * g4 + 0] * rs * wv.x, O[d][4 * g4 + 1] * rs * wv.y); o.y = pk2(O[d][4 * g4 + 2] * rs * wv.z, O[d][4 * g4 + 3] * rs * wv.w);
                    *(v2u*)(op + dv) = o; }
        }
    }
    __syncthreads();
}

DI void ph_mixers(const Frame& F0, int layer) {
    constexpr int NDLA = 128, NU = NDLA + NB * 8 * 65;
    gu32* head = (gu32*)(F0.p.ws + WS_CTL) + CW_QUEUE + 64 * layer;
    volatile LAS unsigned* slot = (volatile LAS unsigned*)(F0.lds + MISC_OFF + 64);
    for (;;) {
        __syncthreads();
        if (threadIdx.x == 0) slot[0] = __hip_atomic_fetch_add(head, 1u, RLX_AGENT);
        __syncthreads();
        const int u = (int)__builtin_amdgcn_readfirstlane(slot[0]);
        if (u >= NU) break;
        Frame F = fresh(F0);
        if (u < 64) dla_unit<false>(F, u, layer);
        else if (u < NDLA) dla_unit<true>(F, u - 64, layer);
        else { const int a = u - NDLA, qb = 64 - a / 32, bh = a % 32; attn_unit(F, bh >> 3, bh & 7, qb, layer); }
    }
}

DI unsigned f2key(float x) { const unsigned u = __builtin_bit_cast(unsigned, x); return (u & 0x80000000u) ? ~u : (u | 0x80000000u); }
DI float key2f(unsigned k) { const unsigned u = (k & 0x80000000u) ? (k & 0x7fffffffu) : ~k; return __builtin_bit_cast(float, u); }
DI void kins16(unsigned (&t)[16], unsigned x) {
#pragma unroll
    for (int j = 0; j < 16; ++j) { const unsigned hi = x > t[j] ? x : t[j], lo = x > t[j] ? t[j] : x; t[j] = hi; x = lo; }
}
#define KCE(a, i, l) do { const unsigned hi_ = a[i] > a[l] ? a[i] : a[l], lo_ = a[i] > a[l] ? a[l] : a[i]; a[i] = hi_; a[l] = lo_; } while (0)
DI void ksort16(unsigned (&a)[16]) {
#pragma unroll
    for (int k = 2; k <= 16; k <<= 1)
#pragma unroll
        for (int j = k >> 1; j > 0; j >>= 1)
#pragma unroll
            for (int i = 0; i < 16; ++i) { const int l = i ^ j; if (l > i) { if ((i & k) == 0) KCE(a, i, l); else KCE(a, l, i); } }
}
DI void kmerge16(unsigned (&t)[16], const unsigned (&b)[16]) {
#pragma unroll
    for (int i = 0; i < 16; ++i) t[i] = t[i] > b[15 - i] ? t[i] : b[15 - i];
#pragma unroll
    for (int j = 8; j > 0; j >>= 1)
#pragma unroll
        for (int i = 0; i < 16; ++i) { const int l = i ^ j; if (l > i) KCE(t, i, l); }
}
DI void ktop16_of_128(const bf16* s, unsigned (&t)[16]) {
    for (int blk = 0; blk < 8; ++blk) {
        unsigned b[16];
#pragma unroll
        for (int j = 0; j < 2; ++j) { const v4u w_ = *(const v4u*)(s + 16 * blk + 8 * j); const unsigned k = 127u - (unsigned)(16 * blk + 8 * j);
            b[8 * j] = (f2key(bflo(w_.x)) & ~127u) | k; b[8 * j + 1] = (f2key(bfhi(w_.x)) & ~127u) | (k - 1); b[8 * j + 2] = (f2key(bflo(w_.y)) & ~127u) | (k - 2); b[8 * j + 3] = (f2key(bfhi(w_.y)) & ~127u) | (k - 3);
            b[8 * j + 4] = (f2key(bflo(w_.z)) & ~127u) | (k - 4); b[8 * j + 5] = (f2key(bfhi(w_.z)) & ~127u) | (k - 5); b[8 * j + 6] = (f2key(bflo(w_.w)) & ~127u) | (k - 6); b[8 * j + 7] = (f2key(bfhi(w_.w)) & ~127u) | (k - 7); }
        ksort16(b);
        if (blk == 0) {
#pragma unroll
            for (int j = 0; j < 16; ++j) t[j] = b[j];
        } else kmerge16(t, b);
    }
}
template <int I> DI void kcand_row(const float (&fa)[16], const float (&fb)[16], unsigned (&bt)[16]) {
    constexpr int NJ = 16 / (I + 1);
#pragma unroll
    for (int j = 0; j < NJ; ++j) kins16(bt, (f2key(fa[I] + fb[j]) & ~255u) | (unsigned)(255 - (I * 16 + j)));
}
DI void ph_topk(Frame& F) {
    const bf16* SC = (const bf16*)(F.ws + WS_SCORES); int* IDX = (int*)(F.ws + WS_IDX); float* GT = (float*)(F.ws + WS_GATE);
    const int gt = F.bid * 512 + F.tid, NT = F.G * 512;
    for (int it = gt; it < TP * 8; it += NT) {
        const int r = it >> 3, h = it & 7; const int b = r / TPB, q = r - b * TPB; if (q < PADR) continue;
        const bf16* s = SC + (size_t)r * 2048 + h * 256;
        unsigned ka[16], kb[16];
        ktop16_of_128(s, ka);
        ktop16_of_128(s + 128, kb);
        float fa[16], fb[16];
#pragma unroll
        for (int j = 0; j < 16; ++j) { fa[j] = key2f(ka[j] & ~127u); fb[j] = key2f(kb[j] & ~127u); }
        unsigned bt[16];
#pragma unroll
        for (int j = 0; j < 16; ++j) bt[j] = 0u;
        kcand_row<0>(fa, fb, bt); kcand_row<1>(fa, fb, bt); kcand_row<2>(fa, fb, bt); kcand_row<3>(fa, fb, bt);
        kcand_row<4>(fa, fb, bt); kcand_row<5>(fa, fb, bt); kcand_row<6>(fa, fb, bt); kcand_row<7>(fa, fb, bt);
        kcand_row<8>(fa, fb, bt); kcand_row<9>(fa, fb, bt); kcand_row<10>(fa, fb, bt); kcand_row<11>(fa, fb, bt);
        kcand_row<12>(fa, fb, bt); kcand_row<13>(fa, fb, bt); kcand_row<14>(fa, fb, bt); kcand_row<15>(fa, fb, bt);
        int eo[16]; float ge[16]; float sum = 0.f;
        const float s0 = key2f(bt[0] & ~255u);
#pragma unroll
        for (int k = 0; k < 16; ++k) {
            const int pos = 255 - (int)(bt[k] & 255u), pi = pos >> 4, pj = pos & 15; unsigned e0 = 0, e1 = 0;
#pragma unroll
            for (int j = 0; j < 16; ++j) { e0 = (pi == j) ? ka[j] : e0; e1 = (pj == j) ? kb[j] : e1; }
            eo[k] = (int)((127u - (e0 & 127u)) * 128u + (127u - (e1 & 127u))); ge[k] = __expf(key2f(bt[k] & ~255u) - s0); sum += ge[k];
        }
        const float inv = 1.f / sum;
        int* ip = IDX + (size_t)r * 128 + h * 16; float* gp = GT + (size_t)r * 128 + h * 16;
#pragma unroll
        for (int k = 0; k < 16; k += 4) { *(int4*)(ip + k) = make_int4(eo[k], eo[k + 1], eo[k + 2], eo[k + 3]); *(f32x4*)(gp + k) = (f32x4){ge[k] * inv, ge[k + 1] * inv, ge[k + 2] * inv, ge[k + 3] * inv}; }
    }
}

typedef float f32x2v __attribute__((ext_vector_type(2)));
DI float gelu_exact(float x) { return 0.5f * x * (1.f + erff(x * 0.70710678118654752f)); }
typedef int i32x8v __attribute__((ext_vector_type(8)));
typedef int i32x6v __attribute__((ext_vector_type(6)));
DI void ph_peer_u(Frame& F) {
    const Params& p = F.p;
    const unsigned char* PU = (const unsigned char*)(F.ws + WS_PU);
    const int* IDX = (const int*)(F.ws + WS_IDX); const float* GT = (const float*)(F.ws + WS_GATE);
    const int lane = F.lane;
    const int part = F.bid & 7, np = (F.G - part + 7) >> 3, wi = (F.bid >> 3) * NWAVES + F.wave, nwp = np * NWAVES;
    const __amdgpu_buffer_rsrc_t pur = __builtin_amdgcn_make_buffer_rsrc((void*)PU, 0, 0x7fffffff, 0x00020000);
    constexpr int SETB = 4352;
    LAS unsigned char* hl = F.lds + F.wave * (2 * SETB + 2048);
    LAS unsigned char* zz = hl + 2 * SETB;
    *(LAS v4u*)(zz + 32 * lane) = (v4u){0u, 0u, 0u, 0u}; *(LAS v4u*)(zz + 32 * lane + 16) = (v4u){0u, 0u, 0u, 0u};
    const LAS unsigned char *aL, *aU; int oL, oU;
    { const int i = lane & 15, g = lane >> 4, G = i >> 2, ca = i & 3; const LAS unsigned char* hp = hl + 64 * ca + 16 * (g & 1);
      const bool vl = G == (g >> 1), vu = G == 2 + (g >> 1);
      aL = vl ? hp : zz; aU = vu ? hp : zz; oL = vl ? 1 : 0; oU = vu ? 1 : 0; }
    int r = wi; while (r < TP && (r % TPB) < PADR) r += nwp;
    if (r >= TP) return;
    int i0 = 0, i1 = 0; float g0 = 0.f, g1 = 0.f; v4u hrow[4];
#define PU_FETCH(rr) do { int l_ = lane; asm volatile("" : "+v"(l_)); i0 = IDX[(size_t)(rr) * 128 + l_]; i1 = IDX[(size_t)(rr) * 128 + 64 + l_]; g0 = GT[(size_t)(rr) * 128 + l_]; g1 = GT[(size_t)(rr) * 128 + 64 + l_]; \
        const unsigned char* x8 = F.ws + WS_H8 + (size_t)(rr) * 4096 + 32 * l_; hrow[0] = *(const v4u*)x8; hrow[1] = *(const v4u*)(x8 + 16); hrow[2] = *(const v4u*)(x8 + 2048); hrow[3] = *(const v4u*)(x8 + 2064); } while (0)
#define PU_STAGE(st) do { int l_ = lane; asm volatile("" : "+v"(l_)); LAS unsigned char* sb_ = hl + (st) * SETB; LAS int* ce_ = (LAS int*)(sb_ + 4096); \
        *(LAS v4u*)(sb_ + 32 * l_) = hrow[0]; *(LAS v4u*)(sb_ + 32 * l_ + 16) = hrow[1]; *(LAS v4u*)(sb_ + 2048 + 32 * l_) = hrow[2]; *(LAS v4u*)(sb_ + 2048 + 32 * l_ + 16) = hrow[3]; \
        int n0_[8], nn_[8]; const int q0 = i0 & 7, q1 = i1 & 7; int ps0 = 0, ps1 = 0; \
        _Pragma("unroll") for (int k = 0; k < 8; ++k) { const unsigned long long b0 = __ballot(q0 == k), b1 = __ballot(q1 == k); n0_[k] = __popcll(b0); nn_[k] = n0_[k] + __popcll(b1); \
            const int m0_ = __builtin_amdgcn_mbcnt_hi((unsigned)(b0 >> 32), __builtin_amdgcn_mbcnt_lo((unsigned)b0, 0u)), m1_ = n0_[k] + __builtin_amdgcn_mbcnt_hi((unsigned)(b1 >> 32), __builtin_amdgcn_mbcnt_lo((unsigned)b1, 0u)); \
            ps0 = (q0 == k) ? m0_ : ps0; ps1 = (q1 == k) ? m1_ : ps1; } \
        int ovb[8], dfb = 0, df = 0, mycnt = 0; { int o = 0, d = 0; \
        _Pragma("unroll") for (int k = 0; k < 8; ++k) { ovb[k] = o; o += nn_[k] > 16 ? nn_[k] - 16 : 0; const int dk = nn_[k] < 16 ? 16 - nn_[k] : 0; if (k == part) { dfb = d; df = dk; mycnt = nn_[k] < 16 ? nn_[k] : 16; } d += dk; } } \
        int ob0 = 0, ob1 = 0; \
        _Pragma("unroll") for (int k = 0; k < 8; ++k) { ob0 = (q0 == k) ? ovb[k] : ob0; ob1 = (q1 == k) ? ovb[k] : ob1; } \
        { int lp = -1; if (q0 == part && ps0 < 16) lp = ps0; else if (ps0 >= 16) { const int gi = ob0 + ps0 - 16 - dfb; if (gi >= 0 && gi < df) lp = mycnt + gi; } \
          if (lp >= 0) { ce_[lp] = i0; ce_[16 + lp] = l_; ((LAS float*)ce_)[32 + lp] = g0; } } \
        { int lp = -1; if (q1 == part && ps1 < 16) lp = ps1; else if (ps1 >= 16) { const int gi = ob1 + ps1 - 16 - dfb; if (gi >= 0 && gi < df) lp = mycnt + gi; } \
          if (lp >= 0) { ce_[lp] = i1; ce_[16 + lp] = 64 + l_; ((LAS float*)ce_)[32 + lp] = g1; } } } while (0)
#define PU_OFF(st, dst) do { int l_ = lane; asm volatile("" : "+v"(l_)); dst = (unsigned)((const LAS int*)(hl + (st) * SETB + 4096))[l_ >> 2] * 1536u + 48u * (unsigned)(l_ & 3); } while (0)
#define PU_LOAD(buf, off_, half) do { _Pragma("unroll") for (int p4 = 0; p4 < 4; ++p4) _Pragma("unroll") for (int c = 0; c < 3; ++c) buf[p4][c] = __builtin_amdgcn_raw_buffer_load_b128(pur, (off_) + 16 * c, 192 * (4 * (half) + p4), 0); } while (0)
#define PU_A(lo_, up_, o) __builtin_shufflevector(__builtin_bit_cast(pg8::i32x4, *(const LAS v4u*)((lo_) + (o))), __builtin_bit_cast(pg8::i32x4, *(const LAS v4u*)((up_) + (o))), 0, 1, 2, 3, 4, 5, 6, 7)
#define PU_MMA(buf, half) do { _Pragma("unroll") for (int p4 = 0; p4 < 4; ++p4) _Pragma("unroll") for (int t = 0; t < 2; ++t) { const int o_ = 256 * (4 * (half) + p4) + 32 * t; \
            const i32x8v ah = PU_A(aL + oL * sofs, aU + oU * sofs, o_), al = PU_A(aL + oL * (sofs + 2048), aU + oU * (sofs + 2048), o_); \
            const i32x6v uf = t == 0 ? __builtin_shufflevector(__builtin_bit_cast(pg8::i32x4, buf[p4][0]), __builtin_bit_cast(pg8::i32x4, buf[p4][1]), 0, 1, 2, 3, 4, 5) \
                                     : __builtin_shufflevector(__builtin_bit_cast(pg8::i32x4, buf[p4][1]), __builtin_bit_cast(pg8::i32x4, buf[p4][2]), 2, 3, 4, 5, 6, 7); \
            asm volatile("s_nop 1\n\tv_mfma_f32_16x16x128_f8f6f4 %0, %1, %2, %0 blgp:2" : "+v"(ach) : "v"(ah), "v"(uf)); \
            asm volatile("v_mfma_f32_16x16x128_f8f6f4 %0, %1, %2, %0 blgp:2" : "+v"(acl) : "v"(al), "v"(uf)); } } while (0)
    v4u ua[4][3], ub[4][3]; unsigned offc, offn = 0u; int st = 0;
    PU_FETCH(r); PU_STAGE(0); PU_OFF(0, offc); PU_LOAD(ua, offc, 0);
    int rn = r + nwp; while (rn < TP && (rn % TPB) < PADR) rn += nwp;
    if (rn < TP) PU_FETCH(rn);
    for (;;) {
        const int sofs = st * SETB; const bool more = rn < TP;
        PU_LOAD(ub, offc, 1);
        if (more) { PU_STAGE(st ^ 1); PU_OFF(st ^ 1, offn); }
        f32x4 ach = (f32x4){0.f, 0.f, 0.f, 0.f}, acl = (f32x4){0.f, 0.f, 0.f, 0.f};
        PU_MMA(ua, 0);
        if (more) PU_LOAD(ua, offn, 0);
        PU_MMA(ub, 1);
        int rnn = rn + nwp; while (rnn < TP && (rnn % TPB) < PADR) rnn += nwp;
        if (more && rnn < TP) PU_FETCH(rnn);
        asm volatile("s_nop 7\n\ts_nop 7\n\ts_nop 7" : "+v"(ach), "+v"(acl));
        { int ln = lane; asm volatile("" : "+v"(ln)); const int cq = ln & 3, idx = ln >> 2;
          const f32x4 v = ach + acl * (1.f / PEER_LO);
          float d = cq == 0 ? v.x : cq == 1 ? v.y : cq == 2 ? v.z : v.w;
          d += __shfl_xor(d, 1); d += __shfl_xor(d, 2);
          if (cq == 0) { const LAS int* ce_ = (const LAS int*)(hl + sofs + 4096); const int e = ce_[idx], slot = ce_[16 + idx]; const float g = ((const LAS float*)ce_)[32 + idx];
              constexpr float DS = 1.f / (PEER_HS * PEER_USCALE); const int b = r / TPB, q = r - b * TPB;
              int* PK = (int*)(F.ws + WS_PK); const int di = b * (SEQ + META) + (q - PADR); int* pb = PK + ((size_t)(di >> 6) * 32 * 64 + (di & 63)) * 4;
              pb[(size_t)(slot >> 2) * 256 + (slot & 3)] = (e << 16) | (int)f2bf(g * gelu_exact(d * DS)); } }
        if (!more) break;
        r = rn; rn = rnn; st ^= 1; offc = offn;
    }
#undef PU_FETCH
#undef PU_STAGE
#undef PU_OFF
#undef PU_LOAD
#undef PU_A
#undef PU_MMA
}
DI void ph_peer_v(Frame& F, int layer) {
    const Params& p = F.p;
    const int* PK = (const int*)(F.ws + WS_PK);
    LAS v2u* VL = (LAS v2u*)F.lds;
    constexpr int NREAL = NB * (SEQ + META);
    for (int s0 = F.bid; s0 < DM / 8; s0 += F.G) {
        const int sl = (s0 & 7) * 32 + (s0 >> 3);
        const int dcol = 8 * sl;
        { const v4u* src = (const v4u*)(F.ws + WS_PV) + (size_t)sl * (NEXP / 2);
#pragma unroll 4
          for (int i = F.tid; i < NEXP / 2; i += 512) ((LAS v4u*)VL)[i] = src[i]; }
        __syncthreads();
        for (int i = F.wave * 64 + F.lane; i < NREAL; i += 512) {
            const int b = i / (SEQ + META), q = i - b * (SEQ + META); const int r = b * TPB + PADR + q;
            const int4* ip = (const int4*)PK + (size_t)(i >> 6) * 32 * 64 + (i & 63);
            f32x2v y2[4];
#pragma unroll
            for (int j = 0; j < 4; ++j) y2[j] = (f32x2v){0.f, 0.f};
#define PV_ACC(pk) do { const v2u vv = VL[(unsigned)(pk) >> 16]; const float wt = __builtin_bit_cast(float, (unsigned)(pk) << 16); \
                    const f32x2v a0 = __builtin_amdgcn_cvt_pk_f32_fp8((int)vv.x, false), a1 = __builtin_amdgcn_cvt_pk_f32_fp8((int)vv.x, true), a2 = __builtin_amdgcn_cvt_pk_f32_fp8((int)vv.y, false), a3 = __builtin_amdgcn_cvt_pk_f32_fp8((int)vv.y, true); \
                    const f32x2v w2 = (f32x2v){wt, wt}; y2[0] = __builtin_elementwise_fma(a0, w2, y2[0]); y2[1] = __builtin_elementwise_fma(a1, w2, y2[1]); y2[2] = __builtin_elementwise_fma(a2, w2, y2[2]); y2[3] = __builtin_elementwise_fma(a3, w2, y2[3]); } while (0)
            int4 ea = ip[0], eb = ip[64], ec = ip[128], ed = ip[192];
            for (int k4 = 0; k4 < 32; k4 += 4) {
                const int4 ca = ea, cb = eb, cc = ec, cd = ed;
                if (k4 + 4 < 32) { ea = ip[64 * (k4 + 4)]; eb = ip[64 * (k4 + 5)]; ec = ip[64 * (k4 + 6)]; ed = ip[64 * (k4 + 7)]; }
                PV_ACC(ca.x); PV_ACC(ca.y); PV_ACC(ca.z); PV_ACC(ca.w); PV_ACC(cb.x); PV_ACC(cb.y); PV_ACC(cb.z); PV_ACC(cb.w);
                PV_ACC(cc.x); PV_ACC(cc.y); PV_ACC(cc.z); PV_ACC(cc.w); PV_ACC(cd.x); PV_ACC(cd.y); PV_ACC(cd.z); PV_ACC(cd.w);
            }
#undef PV_ACC
            bf16* yo = (bf16*)(F.ws + WS_Y) + (size_t)r * DM + dcol;
            const float isc = 1.f / PEER_VSCALE;
            *(v4u*)yo = (v4u){pk2(y2[0].x * isc, y2[0].y * isc), pk2(y2[1].x * isc, y2[1].y * isc), pk2(y2[2].x * isc, y2[2].y * isc), pk2(y2[3].x * isc, y2[3].y * isc)};
        }
        __syncthreads();
    }
}

constexpr int PH_PER_LAYER = 13, N_PHASES = 1 + DEPTH * PH_PER_LAYER + 1;

#define IN(k) (lo <= (k) && (k) < hi)
#define SEAM(k) do { if (IN(k) && IN((k) + 1)) xcd_barrier(bar); } while (0)

template <int LAYER>
DI void layer_phases(const Frame& F0, const XcdBarrier& bar, const int lo, const int hi) {
    constexpr int layer = LAYER, base = 1 + LAYER * PH_PER_LAYER;
    const Params& prm = F0.p;
    if (IN(base + 0)) { Frame F = fresh(F0); ph_weights(F, layer); __syncthreads(); ph_norm(F, prm.mix_norm_w + layer * DM, layer == 0, layer != 0, true); } SEAM(base + 0);
    if (IN(base + 1)) { Frame F = fresh(F0); unsigned char* ws = F.ws;
        pg8::Gemm g{(const bf16*)(ws + WS_U), (const bf16*)(ws + WS_WTA), TP, NA_COLS, DM, DM, DM, 0}; pg8::StaticOrder S; S.init(TP, NA_COLS, F.G, F.bid);
        EpiInA E{ws};
        pg8::gemm_phase<EpiInA, pg8::StaticOrder>(F.lds, g, S, E);
    } SEAM(base + 1);
    if (IN(base + 2)) {
        { Frame F = fresh(F0); ph_conv(F, layer); }
        { Frame F = fresh(F0); ph_rope_apply(F); }
        { Frame F = fresh(F0); ph_vtranspose(F); }
    } SEAM(base + 2);
    if (IN(base + 3)) { ph_mixers(F0, layer); } SEAM(base + 3);
    if (IN(base + 4)) {
        { Frame F = fresh(F0); ph_mlfinal(F, layer); }
        Frame F = fresh(F0); unsigned char* ws = F.ws;
        pg8::Gemm g{(const bf16*)(ws + WS_U8), (const bf16*)(ws + WS_WTG), TP, NG_COLS, DM, DM, DM, 0}; pg8::StaticOrder S; S.init(TP, NG_COLS, F.G, F.bid);
        EpiGates E{(unsigned char*)(ws + WS_GATES)};
        pg8::gemm_phase<EpiGates, pg8::StaticOrder, true>(F.lds, g, S, E);
    } SEAM(base + 4);
    if (IN(base + 5)) {
        { Frame F = fresh(F0); unsigned char* ws = F.ws; pg8::StaticOrder S; S.init(TP, DM, F.G, F.bid);
          pg8::Gemm g{(const bf16*)(ws + WS_Z), (const bf16*)(ws + WS_WTB), TP, DM, 1024, 1024, 1024, 0};
          EpiMerge<0> E{(const unsigned char*)(ws + WS_GATES), (bf16*)(ws + WS_U), (const float*)(ws + WS_RSTD)}; pg8::gemm_phase<EpiMerge<0>, pg8::StaticOrder>(F.lds, g, S, E); }
        asm volatile("s_waitcnt vmcnt(0)" ::: "memory"); __syncthreads();
        { Frame F = fresh(F0); unsigned char* ws = F.ws; pg8::StaticOrder S; S.init(TP, DM, F.G, F.bid);
          pg8::Gemm g{(const bf16*)(ws + WS_MO), (const bf16*)(ws + WS_WTB) + (size_t)DM * 1024, TP, DM, 1024, 1024, 1024, 0};
          EpiMerge<1> E{(const unsigned char*)(ws + WS_GATES), (bf16*)(ws + WS_U), nullptr}; pg8::gemm_phase<EpiMerge<1>, pg8::StaticOrder>(F.lds, g, S, E); }
        asm volatile("s_waitcnt vmcnt(0)" ::: "memory"); __syncthreads();
        { Frame F = fresh(F0); unsigned char* ws = F.ws; pg8::StaticOrder S; S.init(TP, DM, F.G, F.bid);
          pg8::Gemm g{(const bf16*)(ws + WS_AQ), (const bf16*)(ws + WS_WTB) + (size_t)2 * DM * 1024, TP, DM, 1024, 1024, 1024, 0};
          EpiMerge<2> E{(const unsigned char*)(ws + WS_GATES), (bf16*)(ws + WS_U), nullptr}; pg8::gemm_phase<EpiMerge<2>, pg8::StaticOrder>(F.lds, g, S, E); }
    } SEAM(base + 5);
    if (IN(base + 6)) { Frame F = fresh(F0); unsigned char* ws = F.ws;
        pg8::Gemm g{(const bf16*)(ws + WS_U), (const bf16*)(ws + WS_WTO), TP, DM, DM, DM, DM, 0}; pg8::StaticOrder S; S.init(TP, DM, F.G, F.bid);
        EpiResid E{prm, ws}; pg8::gemm_phase<EpiResid, pg8::StaticOrder>(F.lds, g, S, E);
    } SEAM(base + 6);
    if (IN(base + 7)) { Frame F = fresh(F0); ph_norm(F, prm.ffn_norm_w + layer * DM, false, false, false, true); } SEAM(base + 7);
    if (IN(base + 8)) { Frame F = fresh(F0); unsigned char* ws = F.ws;
        pg8::Gemm g{(const bf16*)(ws + WS_U), (const bf16*)(ws + WS_WTQ), TP, DM, DM, DM, DM, 0}; pg8::StaticOrder S; S.init(TP, DM, F.G, F.bid);
        EpiBf16 E{(bf16*)(ws + WS_QP), DM}; pg8::gemm_phase<EpiBf16, pg8::StaticOrder>(F.lds, g, S, E);
    } SEAM(base + 8);
    if (IN(base + 9)) { Frame F = fresh(F0); unsigned char* ws = F.ws;
        pg8::Gemm g{(const bf16*)(ws + WS_QP), (const bf16*)(ws + WS_SKP), TP, DM, 256, DM, 256, 256}; pg8::StaticOrder S; S.init(TP, DM, F.G, F.bid);
        EpiBf16 E{(bf16*)(ws + WS_SCORES), DM}; pg8::gemm_phase<EpiBf16, pg8::StaticOrder>(F.lds, g, S, E);
    } SEAM(base + 9);
    if (IN(base + 10)) { Frame F = fresh(F0); ph_topk(F); } SEAM(base + 10);
    if (IN(base + 11)) { Frame F = fresh(F0); ph_peer_u(F); } SEAM(base + 11);
    if (IN(base + 12)) { Frame F = fresh(F0); ph_peer_v(F, layer); } SEAM(base + 12);
}

__global__ void __launch_bounds__(NWAVES * 64, 2) fwd_kernel(Params prm) {
    extern __shared__ __attribute__((aligned(16))) unsigned char lds_raw[];
    const int tid_ = threadIdx.x;
    Frame F0{(LAS unsigned char*)lds_raw, tid_, tid_ & 63, __builtin_amdgcn_readfirstlane(tid_ >> 6), (int)gridDim.x, (int)blockIdx.x, prm.ws, prm};
    volatile LAS unsigned* MISC = (volatile LAS unsigned*)(F0.lds + MISC_OFF);
    for (int u = tid_; u < (LDS_BYTES - LDSCTL_OFF) / 4; u += NWAVES * 64) ((LAS unsigned*)(F0.lds + LDSCTL_OFF))[u] = 0u;
    __syncthreads();
    const int lo = prm.ph_lo, hi = prm.ph_hi;
    const bool multi = (hi - lo) > 1;
    XcdBarrier bar; bar.bar = (unsigned*)(prm.ws + WS_CTL) + CW_BAR; bar.x = 0; bar.st = nullptr;
    if (multi) bar = xcd_barrier_post((unsigned*)(prm.ws + WS_CTL) + CW_BAR, MISC + 8);

    if (IN(0)) { Frame F = fresh(F0); ph_rope(F); } SEAM(0);
    layer_phases<0>(F0, bar, lo, hi);
    layer_phases<1>(F0, bar, lo, hi);
    if (IN(N_PHASES - 1)) { Frame F = fresh(F0); ph_final(F); }
}
#undef IN
#undef SEAM

extern "C" void kernel_launch(void* const* d_in, const int* in_sizes, int n_in, void* d_out, int out_size, void* d_ws, size_t ws_size, hipStream_t stream) {
    static int grid = 0;
    if (grid == 0) {
        if (n_in != 29 || ws_size < WS_END) { fprintf(stderr, "kernel_launch: unexpected inputs (n_in %d, ws %zu, need %zu)\n", n_in, ws_size, (size_t)WS_END); grid = -1; return; }
        int dev = 0, cus = 0, per_cu = 0;
        if (hipGetDevice(&dev) != hipSuccess || hipDeviceGetAttribute(&cus, hipDeviceAttributeMultiprocessorCount, dev) != hipSuccess) { grid = -1; return; }
        if (hipFuncSetAttribute((const void*)fwd_kernel, hipFuncAttributeMaxDynamicSharedMemorySize, LDS_BYTES) != hipSuccess) { fprintf(stderr, "kernel_launch: hipFuncSetAttribute failed\n"); grid = -1; return; }
        if (hipOccupancyMaxActiveBlocksPerMultiprocessor(&per_cu, (const void*)fwd_kernel, NWAVES * 64, LDS_BYTES) != hipSuccess || per_cu < 1) fprintf(stderr, "kernel_launch: occupancy query reports %d\n", per_cu);
        (void)hipGetLastError();
        grid = cus;
    }
    if (grid < 0) return;
    (void)hipMemsetAsync((char*)d_ws + WS_CTL, 0, CTL_ZERO_BYTES, stream);
    Params p{};
    p.x = (const float*)d_in[0]; p.positions = (const int*)d_in[1]; p.meta = (const float*)d_in[2]; p.mix_norm_w = (const float*)d_in[3]; p.w_in = (const float*)d_in[4];
    p.conv_w = (const float*)d_in[5]; p.conv_b = (const float*)d_in[6]; p.dt_bias = (const float*)d_in[7]; p.a_log = (const float*)d_in[8]; p.ssd_d = (const float*)d_in[9];
    p.ssd_norm_w = (const float*)d_in[10]; p.i_bias = (const float*)d_in[11]; p.f_bias = (const float*)d_in[12]; p.ml_norm_w = (const float*)d_in[13];
    p.lq1 = (const float*)d_in[14]; p.lk1 = (const float*)d_in[15]; p.lq2 = (const float*)d_in[16]; p.lk2 = (const float*)d_in[17]; p.diff_norm_w = (const float*)d_in[18];
    p.w_bs = (const float*)d_in[19]; p.w_bm = (const float*)d_in[20]; p.w_bd = (const float*)d_in[21]; p.w_out = (const float*)d_in[22]; p.ffn_norm_w = (const float*)d_in[23];
    p.peer_wq = (const float*)d_in[24]; p.sub_keys = (const float*)d_in[25]; p.peer_u = (const float*)d_in[26]; p.peer_v = (const float*)d_in[27]; p.final_norm_w = (const float*)d_in[28];
    p.out = (float*)d_out; p.ws = (unsigned char*)d_ws;
#if MK_N_LAUNCHES == 1
    p.ph_lo = 0; p.ph_hi = N_PHASES;
    hipLaunchKernelGGL(fwd_kernel, dim3(grid), dim3(NWAVES * 64), LDS_BYTES, stream, p);
#else
    for (int ph = 0; ph < N_PHASES; ++ph) { p.ph_lo = ph; p.ph_hi = ph + 1; hipLaunchKernelGGL(fwd_kernel, dim3(grid), dim3(NWAVES * 64), LDS_BYTES, stream, p); }
#endif
    const hipError_t le = hipPeekAtLastError();
    if (le != hipSuccess) fprintf(stderr, "kernel_launch: launch failed: %s\n", hipGetErrorName(le));
}
```

```cpp
#include <hip/hip_runtime.h>
#include <cstdio>
#include <cstdint>

#ifndef MK_N_LAUNCHES
#define MK_N_LAUNCHES 1
#endif

constexpr int NB = 4, SEQ = 8192, DM = 2048, META = 16, PADR = 112;
constexpr int TPB = SEQ + META + PADR;
constexpr int TP = NB * TPB;
constexpr int N_IN = 14872;
constexpr int NA_COLS = 35 * 256;
constexpr int NG_COLS = 6144;
constexpr float EPS = 1e-6f;
constexpr int NEXP = 16384;
constexpr int DEPTH = 2;
constexpr float PEER_USCALE = 64.f, PEER_VSCALE = 16.f;

constexpr size_t MiB = 1u << 20;
constexpr size_t WS_CTL = 0, CTL_ZERO_BYTES = 1 * MiB;
constexpr size_t WS_ROPE = 1 * MiB;
constexpr size_t WS_HMETA = 3 * MiB + 256 * 1024;
constexpr size_t WS_RSTD = 3 * MiB + 768 * 1024;
constexpr size_t WS_SMALL = 4 * MiB;
constexpr size_t WS_SSQ = 9 * MiB;
constexpr size_t WS_SSQM = 14 * MiB;
constexpr size_t WS_WTA = 19 * MiB;
constexpr size_t WS_WTG = 54 * MiB;
constexpr size_t WS_WTB = 78 * MiB;
constexpr size_t WS_WTO = 90 * MiB;
constexpr size_t WS_WTQ = 98 * MiB;
constexpr size_t WS_SKP = 66 * MiB;
constexpr size_t WS_PU = 106 * MiB;
constexpr size_t WS_PV = 138 * MiB;
constexpr size_t WS_U8 = 170 * MiB;
constexpr size_t WS_U = 235 * MiB;
constexpr size_t WS_Z = 365 * MiB;
constexpr size_t WS_MO = 430 * MiB;
constexpr size_t WS_AQ = 495 * MiB;
constexpr size_t WS_MV = 560 * MiB;
constexpr size_t WS_OVL = 625 * MiB;
constexpr size_t WS_XBC = WS_OVL;
constexpr size_t WS_MQ = WS_XBC + (size_t)TP * 1536 * 2;
constexpr size_t WS_MK = WS_MQ + (size_t)TP * 512 * 2;
constexpr size_t WS_AK = WS_MK + (size_t)TP * 512 * 2;
constexpr size_t WS_AV = WS_AK + (size_t)TP * 1024 * 2;
constexpr size_t WS_VT = WS_AV + (size_t)TP * 1024 * 2;
constexpr size_t WS_GATES = WS_OVL;
constexpr size_t WS_SCORES = WS_OVL;
constexpr size_t WS_Y = WS_Z;
constexpr size_t WS_PK = WS_OVL;
constexpr size_t WS_QP = WS_Z;
constexpr size_t WS_IDX = WS_OVL + 390 * MiB;
constexpr size_t WS_GATE = WS_IDX + (size_t)TP * 128 * 4;
constexpr size_t WS_XCB = WS_VT + (size_t)TP * 1024 * 2;
constexpr size_t WS_XCX = WS_GATE + (size_t)TP * 128 * 4;
constexpr size_t WS_END = WS_XCX + (size_t)TP * 1024 * 2;
static_assert(WS_XCB + (size_t)TP * 512 * 2 <= WS_OVL + 390 * MiB, "overlay");
static_assert(WS_END <= 1168891328ull, "workspace budget (sum of the inputs)");

constexpr int CW_TMO = 0;
constexpr int CW_BAR = 4096;
constexpr int CW_QUEUE = 8192;

constexpr int LDS_BYTES = 163840;
constexpr int LDSCTL_OFF = LDS_BYTES - 512, MISC_OFF = LDSCTL_OFF + 64;
constexpr int NWAVES = 8;

#define GAS __attribute__((address_space(1)))
#define LAS __attribute__((address_space(3)))
typedef unsigned short bf16;
typedef unsigned v4u __attribute__((ext_vector_type(4)));
typedef unsigned v2u __attribute__((ext_vector_type(2)));
typedef float f32x4 __attribute__((ext_vector_type(4)));
typedef float f32x16 __attribute__((ext_vector_type(16)));
typedef short bf16x8 __attribute__((ext_vector_type(8)));
typedef GAS unsigned gu32;
#define RLX_AGENT __ATOMIC_RELAXED, __HIP_MEMORY_SCOPE_AGENT
#define DI __device__ __forceinline__

DI unsigned f2bf(float f) { unsigned u = __builtin_bit_cast(unsigned, f); return (u + 0x7fffu + ((u >> 16) & 1u)) >> 16; }
typedef float f32x2_t __attribute__((ext_vector_type(2))); typedef __bf16 bf16x2_t __attribute__((ext_vector_type(2)));
DI unsigned pk2(float lo, float hi) { f32x2_t v = {lo, hi}; bf16x2_t b = __builtin_convertvector(v, bf16x2_t); return __builtin_bit_cast(unsigned, b); }
DI float bflo(unsigned w) { return __builtin_bit_cast(float, w << 16); }
DI float bfhi(unsigned w) { return __builtin_bit_cast(float, w & 0xffff0000u); }
DI float wave_sum(float v) {
#pragma unroll
    for (int o = 1; o < 64; o <<= 1) v += __shfl_xor(v, o);
    return v;
}
DI float sigmoidf_(float x) { return __builtin_amdgcn_rcpf(1.f + __builtin_amdgcn_exp2f(-1.4426950408889634f * x)); }
DI float siluf_(float x) { return x * sigmoidf_(x); }
DI unsigned pk4f8(float a, float b, float c, float d) { int pk = __builtin_amdgcn_cvt_pk_fp8_f32(a, b, 0, false); pk = __builtin_amdgcn_cvt_pk_fp8_f32(c, d, pk, true); return (unsigned)pk; }
typedef __bf16 bf16x32v __attribute__((ext_vector_type(32)));
typedef unsigned u32x6v __attribute__((ext_vector_type(6)));
DI unsigned fp6enc(float x) {
    const unsigned ux = __builtin_bit_cast(unsigned, x);
    const float a = fminf(__builtin_fabsf(x), 7.5f);
    unsigned u = __builtin_bit_cast(unsigned, a); u += 0x7FFFFu + ((u >> 20) & 1u);
    const unsigned cn = (u >> 20) - (126u << 3);
    const unsigned cs = (unsigned)__builtin_rintf(a * 8.f);
    return ((ux >> 31) << 5) | (a < 1.f ? cs : cn);
}
constexpr float G8_ASCALE = 16.f, G8_BSCALE = 1024.f;

namespace pg8 {
#define PG8_LAS __attribute__((address_space(3)))
typedef unsigned short bf16_t;
typedef short bf16x8 __attribute__((ext_vector_type(8)));
typedef float f32x4 __attribute__((ext_vector_type(4)));
typedef unsigned u32x4 __attribute__((ext_vector_type(4)));
typedef int i32x4 __attribute__((ext_vector_type(4)));
constexpr int BM = 256, BK = 64, HALF = 128, HTB = HALF * BK * 2, STAGE_BYTES = 8 * HTB, NXCD = 8, WGM = 6;

__host__ __device__ __forceinline__ int lds_byte(int r, int c) { const int st = (r >> 4) * 2 + (c >> 5), rr = r & 15, cc = c & 31, ob = rr * 64 + cc * 2; return st * 1024 + (ob ^ (((ob >> 9) & 1) << 5)); }
__host__ __device__ __forceinline__ void stage_rc(int b, int& R, int& C) { const int st = b / 1024, sb = b % 1024, swz = sb ^ (((sb >> 9) & 1) << 5); R = (st >> 1) * 16 + swz / 64; C = (st & 1) * 32 + (swz % 64) / 2; }
__host__ __device__ __forceinline__ int perm32(int rho) { const int n = rho >> 4, i = rho & 15; return 8 * (i >> 2) + 4 * n + (i & 3); }

struct Unit { int pm, pn; };
struct Gemm { const bf16_t* A; const bf16_t* Bt; int M, N, K, lda, ldb, akoff; };

struct StaticOrder {
    int nM, nN, nwg, G, c;
    __host__ __device__ void init(int M, int N, int G_, int c_) { nM = M / BM; nN = N / BM; nwg = nM * nN; G = G_; c = c_; }
    __host__ __device__ bool next(int i, Unit& u) const {
        const long L = (long)i * G + c; if (L >= nwg) return false;
        int wgid = (int)L; { const int q = nwg / NXCD, r = nwg % NXCD, xcd = wgid % NXCD, off = wgid / NXCD; wgid = (xcd < r ? xcd * (q + 1) : r * (q + 1) + (xcd - r) * q) + off; }
        const int nig = WGM * nN, gid = wgid / nig, fm = gid * WGM, gsz = (nM - fm) < WGM ? (nM - fm) : WGM;
        u.pm = fm + ((wgid % nig) % gsz); u.pn = (wgid % nig) / gsz; return true;
    }
};

__device__ __forceinline__ unsigned cvt_pk_bf16(float lo, float hi) { unsigned r; asm volatile("v_cvt_pk_bf16_f32 %0, %1, %2" : "=v"(r) : "v"(lo), "v"(hi)); return r; }

template <class Epi, class Sched, bool F8 = false>
__device__ __forceinline__ void gemm_phase(PG8_LAS unsigned char* lds, const Gemm g, const Sched& S, const Epi& E) {
    int tid_l = threadIdx.x; asm volatile("" : "+v"(tid_l));
    const int tid = tid_l, wid = __builtin_amdgcn_readfirstlane(tid >> 6), lane = tid & 63, wr = wid >> 2, wc = wid & 3, fr = lane & 15, fq = lane >> 4;
    constexpr int ES = F8 ? 1 : 2;
    const int K = g.K, nt = K * ES / (BK * 2);
    unsigned voffA[2], voffB[2];
#pragma unroll
    for (int i = 0; i < 2; ++i) { int R, C; stage_rc(tid * 16 + i * 8192, R, C); const int Rb = ((R & ~31) + perm32(R & 31));
        voffA[i] = (unsigned)(R * g.lda * ES + C * 2); voffB[i] = (unsigned)(Rb * g.ldb * ES + C * 2); }
    const size_t kstep = (size_t)(BK * 2);
    const size_t hstepA = (size_t)HALF * g.lda * ES, hstepB = (size_t)HALF * g.ldb * ES;
    const size_t tstepA = 2 * hstepA, tstepB = 2 * hstepB;
    const unsigned ldsw = (unsigned)wid * 1024u;
    const int aoff = lds_byte(wr * 64 + fr, fq * 8), boff = lds_byte(wc * 32 + fr, fq * 8);
#define PG8_SA(b, h) (((b) * 2 + (h)) * HTB)
#define PG8_SB(b, h) ((4 + (b) * 2 + (h)) * HTB)
#define PG8_STAGE(bufoff, gbase, voff) do { _Pragma("unroll") for (int _i = 0; _i < 2; ++_i) \
        __builtin_amdgcn_global_load_lds((const unsigned*)((const char*)(gbase) + (voff)[_i]), (PG8_LAS unsigned*)(lds + (bufoff) + ldsw + _i * 8192), 16, 0, 0); } while (0)
#define PG8_LDA(dst, b, h) do { _Pragma("unroll") for (int m = 0; m < 4; ++m) _Pragma("unroll") for (int k = 0; k < 2; ++k) dst[m][k] = *(const PG8_LAS bf16x8*)(lds + PG8_SA(b, h) + aoff + m * 2048 + k * 1024); } while (0)
#define PG8_LDB(dst, b, h) do { _Pragma("unroll") for (int n = 0; n < 2; ++n) _Pragma("unroll") for (int k = 0; k < 2; ++k) dst[n][k] = *(const PG8_LAS bf16x8*)(lds + PG8_SB(b, h) + boff + n * 2048 + k * 1024); } while (0)
#define PG8_CAT(x0, x1) __builtin_shufflevector(__builtin_bit_cast(i32x4, x0), __builtin_bit_cast(i32x4, x1), 0, 1, 2, 3, 4, 5, 6, 7)
#define PG8_MMA(ai, bj, At, Bt) do { __builtin_amdgcn_s_setprio(1); _Pragma("unroll") for (int m = 0; m < 4; ++m) _Pragma("unroll") for (int n = 0; n < 2; ++n) { \
        if constexpr (F8) asm volatile("v_mfma_f32_16x16x128_f8f6f4 %0, %1, %2, %0" : "+v"(acc[ai][bj][m][n]) : "v"(PG8_CAT(Bt[n][0], Bt[n][1])), "v"(PG8_CAT(At[m][0], At[m][1])));     \
        else { _Pragma("unroll") for (int k = 0; k < 2; ++k) acc[ai][bj][m][n] = __builtin_amdgcn_mfma_f32_16x16x32_bf16(Bt[n][k], At[m][k], acc[ai][bj][m][n], 0, 0, 0); } } __builtin_amdgcn_s_setprio(0); } while (0)
#define PG8_WAIT_V(n) asm volatile("s_waitcnt vmcnt(" #n ")" ::: "memory")
#define PG8_WAIT_L(n) asm volatile("s_waitcnt lgkmcnt(" #n ")" ::: "memory")
#define PG8_BAR __builtin_amdgcn_s_barrier()
#define PG8_SCHED __builtin_amdgcn_sched_barrier(0)
    Unit cur, nxt; int ui = 0;
    if (!S.next(0, cur)) return;
    f32x4 acc[2][2][4][2];
#pragma unroll
    for (int a = 0; a < 2; ++a)
#pragma unroll
        for (int b = 0; b < 2; ++b)
#pragma unroll
            for (int m = 0; m < 4; ++m)
#pragma unroll
                for (int n = 0; n < 2; ++n) acc[a][b][m][n] = (f32x4){0.f, 0.f, 0.f, 0.f};
    bf16x8 At[4][2], B0[2][2], B1[2][2];
    const char* cA = (const char*)g.A + (size_t)cur.pm * tstepA + (size_t)cur.pn * g.akoff * 2; const char* cB = (const char*)g.Bt + (size_t)cur.pn * tstepB;
    PG8_STAGE(PG8_SB(0, 0), cB, voffB); PG8_STAGE(PG8_SB(0, 1), cB + hstepB, voffB); PG8_STAGE(PG8_SA(0, 0), cA, voffA); PG8_STAGE(PG8_SA(0, 1), cA + hstepA, voffA);
    if (wr == 1) PG8_BAR;
    PG8_WAIT_V(2); PG8_BAR;
    PG8_STAGE(PG8_SB(1, 0), cB + kstep, voffB); PG8_STAGE(PG8_SA(1, 0), cA + kstep, voffA); PG8_STAGE(PG8_SB(1, 1), cB + hstepB + kstep, voffB);
    PG8_WAIT_V(6); PG8_BAR;
    for (;;) {
        const bool has_next = S.next(ui + 1, nxt);
        const char* nA = has_next ? (const char*)g.A + (size_t)nxt.pm * tstepA + (size_t)nxt.pn * g.akoff * 2 : cA; const char* nB = has_next ? (const char*)g.Bt + (size_t)nxt.pn * tstepB : cB;
#pragma unroll 1
        for (int t = 0; t < nt; t += 2) {
            const bool last = (t == nt - 2);
            const char* a1 = cA + (size_t)(t + 1) * kstep;
            const char* a2 = last ? nA : cA + (size_t)(t + 2) * kstep; const char* b2 = last ? nB : cB + (size_t)(t + 2) * kstep;
            const char* a3 = a2 + kstep; const char* b3 = b2 + kstep;
            PG8_LDB(B0, 0, 0); PG8_LDB(B1, 0, 1); PG8_SCHED; PG8_LDA(At, 0, 0); PG8_STAGE(PG8_SA(1, 1), a1 + hstepA, voffA);
            PG8_WAIT_V(8); PG8_WAIT_L(0); PG8_BAR; PG8_MMA(0, 0, At, B0); PG8_MMA(0, 1, At, B1); PG8_BAR; PG8_SCHED;
            PG8_LDA(At, 0, 1); PG8_STAGE(PG8_SB(0, 0), b2, voffB); PG8_STAGE(PG8_SB(0, 1), b2 + hstepB, voffB); PG8_STAGE(PG8_SA(0, 0), a2, voffA);
            PG8_WAIT_V(8); PG8_WAIT_L(0); PG8_BAR; PG8_MMA(1, 0, At, B0); PG8_MMA(1, 1, At, B1); PG8_BAR; PG8_SCHED;
            PG8_LDB(B0, 1, 0); PG8_LDB(B1, 1, 1); PG8_SCHED; PG8_LDA(At, 1, 0); PG8_STAGE(PG8_SA(0, 1), a2 + hstepA, voffA);
            PG8_WAIT_V(8); PG8_WAIT_L(0); PG8_BAR; PG8_MMA(0, 0, At, B0); PG8_MMA(0, 1, At, B1); PG8_BAR; PG8_SCHED;
            PG8_LDA(At, 1, 1); PG8_STAGE(PG8_SB(1, 0), b3, voffB); PG8_STAGE(PG8_SB(1, 1), b3 + hstepB, voffB); PG8_STAGE(PG8_SA(1, 0), a3, voffA);
            PG8_WAIT_V(8); PG8_WAIT_L(0); PG8_BAR; PG8_MMA(1, 0, At, B0); PG8_MMA(1, 1, At, B1); PG8_BAR; PG8_SCHED;
        }
        if (wr == 0) PG8_BAR;
        if constexpr (F8) {
#define PG8_T(a, b) "+v"(acc[a][b][0][0]), "+v"(acc[a][b][0][1]), "+v"(acc[a][b][1][0]), "+v"(acc[a][b][1][1]), "+v"(acc[a][b][2][0]), "+v"(acc[a][b][2][1]), "+v"(acc[a][b][3][0]), "+v"(acc[a][b][3][1])
            asm volatile("s_nop 7\n\ts_nop 7\n\ts_nop 7" : PG8_T(0, 0), PG8_T(0, 1));
            asm volatile("" : PG8_T(1, 0), PG8_T(1, 1));
#undef PG8_T
        }
        { int fr_ = fr, fq_ = fq; asm volatile("" : "+v"(fr_), "+v"(fq_)); E(acc, cur, wr, wc, fr_, fq_); }
        if (!has_next) break;
#pragma unroll
        for (int a = 0; a < 2; ++a)
#pragma unroll
            for (int b = 0; b < 2; ++b)
#pragma unroll
                for (int m = 0; m < 4; ++m)
#pragma unroll
                    for (int n = 0; n < 2; ++n) acc[a][b][m][n] = (f32x4){0.f, 0.f, 0.f, 0.f};
        cur = nxt; cA = nA; cB = nB; ++ui;
        if (wr == 1) PG8_BAR;
    }
    PG8_WAIT_V(0);
    PG8_BAR;
#undef PG8_SA
#undef PG8_SB
#undef PG8_STAGE
#undef PG8_LDA
#undef PG8_LDB
#undef PG8_MMA
#undef PG8_CAT
#undef PG8_WAIT_V
#undef PG8_WAIT_L
#undef PG8_BAR
#undef PG8_SCHED
}
}

#define XB_TMO      128
#define XB_XCNT(j)  (256  + 64 * (j))
#define XB_XSUB(j)  (1280 + 64 * (j))
#define XB_XGEN(j)  (2304 + 64 * (j))
#define XB_TOP      3328
#define XB_TOPGEN   3392
#define XCD_BAR_WORDS 3456
#define XB_SPIN_CAP (1u << 22)

__device__ __forceinline__ unsigned xb_ld(unsigned* p)              { return __hip_atomic_load(p, __ATOMIC_RELAXED, __HIP_MEMORY_SCOPE_AGENT); }
__device__ __forceinline__ unsigned xb_add(unsigned* p, unsigned v) { return __hip_atomic_fetch_add(p, v, __ATOMIC_RELAXED, __HIP_MEMORY_SCOPE_AGENT); }
__device__ __forceinline__ unsigned xb_xcc_id() { return (unsigned)__builtin_amdgcn_s_getreg((3 << 11) | 20) & 0xFu; }
#define XB_SPIN(cond, bar) do { unsigned _sp = 0; while (cond) { __builtin_amdgcn_s_sleep(1); \
    if ((++_sp & 255u) == 0u) { if (xb_ld(&(bar)[XB_TMO])) break; if (_sp > XB_SPIN_CAP) { atomicAdd(&(bar)[XB_TMO], 1u); break; } } } } while (0)

struct XcdBarrier { unsigned* bar; unsigned x; volatile LAS unsigned* st; };

__device__ __forceinline__ XcdBarrier xcd_barrier_post(unsigned* bar, volatile LAS unsigned* st) {
    XcdBarrier b; b.bar = bar; b.x = xb_xcc_id(); b.st = st;
    if (threadIdx.x == 0) (void)xb_add(&bar[XB_XCNT(b.x)], 1u);
    return b;
}
__device__ __forceinline__ void xcd_barrier_complete(unsigned* bar, unsigned x, unsigned& nloc, unsigned& nx) {
    const unsigned G = gridDim.x * gridDim.y * gridDim.z;
    unsigned sum, cnt, mine, sp = 0u;
    for (;;) {
        sum = 0u; cnt = 0u; mine = 0u;
#pragma unroll
        for (unsigned j = 0; j < 16; ++j) { const unsigned c = xb_ld(&bar[XB_XCNT(j)]); sum += c; cnt += (c > 0u) ? 1u : 0u; mine = (j == x) ? c : mine; }
        if (sum == G) break;
        __builtin_amdgcn_s_sleep(1);
        if ((++sp & 255u) == 0u) { if (xb_ld(&bar[XB_TMO])) break; if (sp > XB_SPIN_CAP) { atomicAdd(&bar[XB_TMO], 1u); break; } }
    }
    nloc = mine > 0u ? mine : 1u; nx = cnt > 0u ? cnt : 1u;
}
__device__ __forceinline__ void xcd_barrier(const XcdBarrier& b) {
    asm volatile("s_waitcnt vmcnt(0)" ::: "memory");
    __syncthreads();
    if (threadIdx.x == 0) {
        unsigned* bar = b.bar;
        __builtin_amdgcn_s_waitcnt(0);
        unsigned nloc = b.st[0], nx = b.st[1];
        if (nloc == 0u) { xcd_barrier_complete(bar, b.x, nloc, nx); b.st[0] = nloc; b.st[1] = nx; }
        const unsigned old = xb_add(&bar[XB_XSUB(b.x)], 1u);
        const unsigned gen = old / nloc;
        if (old + 1u == (gen + 1u) * nloc) {
            __builtin_amdgcn_fence(__ATOMIC_RELEASE, "agent");
            asm volatile("s_waitcnt vmcnt(0)" ::: "memory");
            const unsigned og = xb_add(&bar[XB_TOP], 1u);
            const unsigned tg = og / nx;
            if (og + 1u == (tg + 1u) * nx) xb_add(&bar[XB_TOPGEN], 1u);
            else XB_SPIN(xb_ld(&bar[XB_TOPGEN]) == tg, bar);
            __builtin_amdgcn_fence(__ATOMIC_ACQUIRE, "agent");
            xb_add(&bar[XB_XGEN(b.x)], 1u);
            asm volatile("s_waitcnt vmcnt(0)" ::: "memory");
        } else {
            XB_SPIN(xb_ld(&bar[XB_XGEN(b.x)]) == gen, bar);
            __builtin_amdgcn_fence(__ATOMIC_ACQUIRE, "agent");
            asm volatile("s_waitcnt vmcnt(0)" ::: "memory");
        }
    }
    __syncthreads();
}

struct Params {
    const float* x; const int* positions; const float* meta; const float* mix_norm_w; const float* w_in; const float* conv_w; const float* conv_b;
    const float* dt_bias; const float* a_log; const float* ssd_d; const float* ssd_norm_w; const float* i_bias; const float* f_bias; const float* ml_norm_w;
    const float* lq1; const float* lk1; const float* lq2; const float* lk2; const float* diff_norm_w;
    const float* w_bs; const float* w_bm; const float* w_bd; const float* w_out; const float* ffn_norm_w; const float* peer_wq; const float* sub_keys;
    const float* peer_u; const float* peer_v; const float* final_norm_w;
    float* out; unsigned char* ws;
    int ph_lo, ph_hi;
};

struct Frame {
    LAS unsigned char* lds;
    int tid, lane, wave, G, bid;
    unsigned char* ws;
    const Params& p;
};
DI Frame fresh(const Frame& F) {
    int t = threadIdx.x; asm volatile("" : "+v"(t));
    const unsigned long long wv = (unsigned long long)F.p.ws; unsigned wl = __builtin_amdgcn_readfirstlane((unsigned)wv), wh = __builtin_amdgcn_readfirstlane((unsigned)(wv >> 32));
    asm volatile("" : "+s"(wl), "+s"(wh)); unsigned char* w = (unsigned char*)(GAS unsigned char*)(((unsigned long long)wh << 32) | wl);
    return Frame{F.lds, t, t & 63, __builtin_amdgcn_readfirstlane(t >> 6), F.G, F.bid, w, F.p};
}

DI float* hrow(const Params& p, unsigned char* ws, int r) {
    const int b = r / TPB, q = r - b * TPB;
    if (q >= 128) return p.out + ((size_t)b * SEQ + (q - 128)) * DM;
    if (q >= PADR) return (float*)(ws + WS_HMETA) + (size_t)(b * META + (q - PADR)) * DM;
    return nullptr;
}

DI void ph_rope(Frame& F) {
    float* tab = (float*)(F.ws + WS_ROPE);
    const int gt = F.bid * 512 + F.tid, NT = F.G * 512;
    for (int it = gt; it < TP * 8; it += NT) {
        const int r = it >> 3, i = it & 7, b = r / TPB, q = r - b * TPB;
        float c = 1.f, s = 0.f;
        if (q >= PADR) {
            const int pos = (q >= 128) ? (F.p.positions[b * SEQ + (q - 128)] + META) : (q - PADR);
            const float invf = (float)pow(500000.0, -(double)i / 8.0);
            const float ang = (float)pos * invf;
            c = (float)cos((double)ang); s = (float)sin((double)ang);
        }
        tab[(size_t)r * 16 + i] = c; tab[(size_t)r * 16 + 8 + i] = s;
    }
}

template <class CM, bool F8 = false>
DI void transpose_item(const float* W, int K, int Nsrc, bf16* WT, const CM& cm, const float* kscale, LAS float* scr, int kb, int nb, int lane) {
    const int k0 = 64 * kb, n0 = 32 * nb;
    const int sc = cm(n0 + (lane & 31)); const float nsc = cm.scale(n0 + (lane & 31));
#pragma unroll 8
    for (int i = 0; i < 32; ++i) { const int kk = 2 * i + (lane >> 5); float v = 0.f; if (sc >= 0) v = W[(size_t)(k0 + kk) * Nsrc + sc]; if (kscale) v *= kscale[k0 + kk]; scr[kk * 33 + (lane & 31)] = v * nsc; }
    asm volatile("s_waitcnt lgkmcnt(0)" ::: "memory");
    const int c = lane & 7;
#pragma unroll
    for (int j = 0; j < 4; ++j) { const int n = (lane >> 3) + 8 * j; const LAS float* s = scr + (8 * c) * 33 + n;
        if constexpr (F8) { *(GAS v2u*)((unsigned char*)WT + (size_t)(n0 + n) * K + k0 + 8 * c) = (v2u){pk4f8(s[0 * 33] * G8_BSCALE, s[1 * 33] * G8_BSCALE, s[2 * 33] * G8_BSCALE, s[3 * 33] * G8_BSCALE), pk4f8(s[4 * 33] * G8_BSCALE, s[5 * 33] * G8_BSCALE, s[6 * 33] * G8_BSCALE, s[7 * 33] * G8_BSCALE)}; }
        else { v4u o; o.x = pk2(s[0 * 33], s[1 * 33]); o.y = pk2(s[2 * 33], s[3 * 33]); o.z = pk2(s[4 * 33], s[5 * 33]); o.w = pk2(s[6 * 33], s[7 * 33]);
        *(GAS v4u*)(WT + (size_t)(n0 + n) * K + k0 + 8 * c) = o; } }
    asm volatile("s_waitcnt lgkmcnt(0)" ::: "memory");
}
struct CmA { DI int operator()(int n) const { if (n < 2560) return n; if (n < 4608) return n + 16; if (n < 8704) return n + 24; const int w = n - 8704; if (w < 16) return 2560 + w; if (w < 20) return 4624 + (w - 16); if (w < 24) return 4628 + (w - 20); return -1; }
    DI float scale(int n) const { if (n >= 3072 && n < 3584) return 0.08838834764831845f; if (n >= 5632 && n < 6656) return 0.125f * 1.4426950408889634f; return 1.f; } };
struct CmOff { int off; DI int operator()(int n) const { return n + off; } DI float scale(int) const { return 1.f; } };

DI void ph_weights(Frame& F, int layer) {
    const Params& p = F.p;
    LAS float* scr = (LAS float*)(F.lds + F.wave * 16384);
    const int gw = F.bid * NWAVES + F.wave, NGW = F.G * NWAVES;
    const float* w_in = p.w_in + (size_t)layer * DM * N_IN;
    constexpr int I_A = (DM / 64) * (NA_COLS / 32), I_G = (DM / 64) * (NG_COLS / 32), I_B = (1024 / 64) * (DM / 32), I_O = (DM / 64) * (DM / 32);
    constexpr int NITEMS = I_A + I_G + 3 * I_B + 2 * I_O;
    bf16* WTA = (bf16*)(F.ws + WS_WTA); bf16* WTG = (bf16*)(F.ws + WS_WTG); bf16* WTB = (bf16*)(F.ws + WS_WTB); bf16* WTO = (bf16*)(F.ws + WS_WTO); bf16* WTQ = (bf16*)(F.ws + WS_WTQ);
    for (int it = gw; it < NITEMS; it += NGW) {
        int r = it;
        if (r < I_A) { transpose_item(w_in, DM, N_IN, WTA, CmA(), nullptr, scr, r / (NA_COLS / 32), r % (NA_COLS / 32), F.lane); continue; } r -= I_A;
        if (r < I_G) { transpose_item<CmOff, true>(w_in, DM, N_IN, WTG, CmOff{8728}, nullptr, scr, r / (NG_COLS / 32), r % (NG_COLS / 32), F.lane); continue; } r -= I_G;
        if (r < I_B) { transpose_item(p.w_bs + (size_t)layer * 1024 * DM, 1024, DM, WTB, CmOff{0}, p.ssd_norm_w + layer * 1024, scr, r / (DM / 32), r % (DM / 32), F.lane); continue; } r -= I_B;
        if (r < I_B) { transpose_item(p.w_bm + (size_t)layer * 1024 * DM, 1024, DM, WTB + (size_t)DM * 1024, CmOff{0}, nullptr, scr, r / (DM / 32), r % (DM / 32), F.lane); continue; } r -= I_B;
        if (r < I_B) { transpose_item(p.w_bd + (size_t)layer * 1024 * DM, 1024, DM, WTB + (size_t)2 * DM * 1024, CmOff{0}, nullptr, scr, r / (DM / 32), r % (DM / 32), F.lane); continue; } r -= I_B;
        if (r < I_O) { transpose_item(p.w_out + (size_t)layer * DM * DM, DM, DM, WTO, CmOff{0}, nullptr, scr, r / (DM / 32), r % (DM / 32), F.lane); continue; } r -= I_O;
        transpose_item(p.peer_wq + (size_t)layer * DM * DM, DM, DM, WTQ, CmOff{0}, nullptr, scr, r / (DM / 32), r % (DM / 32), F.lane);
    }
    {
        bf16* SKP = (bf16*)(F.ws + WS_SKP);
        const float* sk = p.sub_keys + (size_t)layer * 2 * 8 * 128 * 128;
        const int gt = F.bid * 512 + F.tid, NT = F.G * 512;
        for (int it = gt; it < 2048 * 256 / 8; it += NT) {
            const int n = it >> 5, k0 = (it & 31) * 8, h = n >> 8, m = (n >> 7) & 1, key = n & 127;
            v4u o = (v4u){0u, 0u, 0u, 0u};
            if ((k0 >> 7) == m) { const float* s = sk + (((size_t)m * 8 + h) * 128 + key) * 128 + (k0 & 127);
                const f32x4 a = *(const f32x4*)s, b = *(const f32x4*)(s + 4);
                o.x = pk2(a.x, a.y); o.y = pk2(a.z, a.w); o.z = pk2(b.x, b.y); o.w = pk2(b.z, b.w); }
            *(v4u*)(SKP + (size_t)n * 256 + k0) = o;
        }
    }
}

DI void ph_tables_dyn(Frame& F, int layer) {
    const Params& p = F.p;
    gu32* head = (gu32*)(p.ws + WS_CTL) + CW_QUEUE + 64 * layer + 32;
    volatile LAS unsigned* slot = (volatile LAS unsigned*)(F.lds + MISC_OFF + 64);
    const float* su = p.peer_u + (size_t)layer * NEXP * DM; unsigned* PU = (unsigned*)(F.ws + WS_PU);
    const float* sv = p.peer_v + (size_t)layer * NEXP * DM; v2u* VS = (v2u*)(F.ws + WS_PV);
    constexpr int TROW = 2056;
    for (;;) {
        __syncthreads();
        if (F.tid == 0) slot[0] = __hip_atomic_fetch_add(head, 1u, RLX_AGENT);
        __syncthreads();
        const int item = (int)__builtin_amdgcn_readfirstlane(slot[0]);
        if (item >= 512) break;
        if (item < 256) {
            const int e0 = 64 * item;
            for (int it = 0; it < 64; ++it) { const int idx = F.tid + 512 * it, row = idx >> 9, c4 = idx & 511;
                const f32x4 a = __builtin_nontemporal_load((const f32x4*)(sv + (size_t)(e0 + row) * DM + 4 * c4)) * PEER_VSCALE;
                int pk = __builtin_amdgcn_cvt_pk_fp8_f32(a.x, a.y, 0, false); pk = __builtin_amdgcn_cvt_pk_fp8_f32(a.z, a.w, pk, true);
                *(LAS unsigned*)(F.lds + row * TROW + 4 * c4) = (unsigned)pk; }
            __syncthreads();
            for (int it = 0; it < 32; ++it) { const int idx = F.tid + 512 * it, sl = idx >> 6, e = idx & 63;
                VS[(size_t)sl * NEXP + e0 + e] = *(const LAS v2u*)(F.lds + e * TROW + 8 * sl); }
        } else {
            for (int k = 0; k < 8; ++k) { const size_t it = (size_t)(item - 256) * 4096 + k * 512 + F.tid;
                const float* s_ = su + it * 32; bf16x32v bv;
#pragma unroll
                for (int j = 0; j < 8; ++j) { const f32x4 a = __builtin_nontemporal_load((const f32x4*)(s_ + 4 * j)) * PEER_USCALE;
                    bv[4 * j] = (__bf16)a.x; bv[4 * j + 1] = (__bf16)a.y; bv[4 * j + 2] = (__bf16)a.z; bv[4 * j + 3] = (__bf16)a.w; }
                const u32x6v o = __builtin_amdgcn_cvt_scalef32_pk32_fp6_bf16(bv, 1.0f);
                unsigned* d = PU + it * 6; *(v2u*)d = (v2u){o[0], o[1]}; *(v2u*)(d + 2) = (v2u){o[2], o[3]}; *(v2u*)(d + 4) = (v2u){o[4], o[5]}; }
        }
    }
}

DI void ph_norm(Frame& F, const float* w, bool init_from_x, bool add_y = false, bool w8 = false) {
    const Params& p = F.p;
    bf16* U = (bf16*)(F.ws + WS_U);
    const int gw = F.bid * NWAVES + F.wave, NGW = F.G * NWAVES;
    for (int r = gw; r < TP; r += NGW) {
        v4u* o = (v4u*)(U + (size_t)r * DM) + F.lane;
        v2u* o8 = (v2u*)(F.ws + WS_U8 + (size_t)r * DM) + F.lane;
        float* h = hrow(p, F.ws, r);
        if (!h) {
#pragma unroll
            for (int j = 0; j < 4; ++j) { o[64 * j] = (v4u){0u, 0u, 0u, 0u}; if (w8) o8[64 * j] = (v2u){0u, 0u}; }
            continue;
        }
        const float* src = h;
        if (init_from_x) { const int b = r / TPB, q = r - b * TPB; src = (q >= 128) ? p.x + ((size_t)b * SEQ + (q - 128)) * DM : p.meta + (size_t)(q - PADR) * DM; }
        f32x4 v[8]; float s = 0.f;
#pragma unroll
        for (int j = 0; j < 4; ++j) { v[2 * j] = *(const f32x4*)(src + 512 * j + 8 * F.lane); v[2 * j + 1] = *(const f32x4*)(src + 512 * j + 8 * F.lane + 4); }
        if (add_y) { const bf16* yr = (const bf16*)(F.ws + WS_Y) + (size_t)r * DM;
#pragma unroll
            for (int j = 0; j < 4; ++j) { const v4u t = *(const v4u*)(yr + 512 * j + 8 * F.lane); v[2 * j] = v[2 * j] + (f32x4){bflo(t.x), bfhi(t.x), bflo(t.y), bfhi(t.y)}; v[2 * j + 1] = v[2 * j + 1] + (f32x4){bflo(t.z), bfhi(t.z), bflo(t.w), bfhi(t.w)}; } }
#pragma unroll
        for (int j = 0; j < 8; ++j) s += (v[j].x * v[j].x + v[j].y * v[j].y) + (v[j].z * v[j].z + v[j].w * v[j].w);
        if (init_from_x || add_y) {
#pragma unroll
            for (int j = 0; j < 4; ++j) { *(f32x4*)(h + 512 * j + 8 * F.lane) = v[2 * j]; *(f32x4*)(h + 512 * j + 8 * F.lane + 4) = v[2 * j + 1]; }
        }
        const float rstd = rsqrtf(wave_sum(s) * (1.f / DM) + EPS);
#pragma unroll
        for (int j = 0; j < 4; ++j) {
            const f32x4 w0 = *(const f32x4*)(w + 512 * j + 8 * F.lane), w1 = *(const f32x4*)(w + 512 * j + 8 * F.lane + 4);
            const f32x4 a = v[2 * j] * rstd * w0, b = v[2 * j + 1] * rstd * w1;
            v4u q; q.x = pk2(a.x, a.y); q.y = pk2(a.z, a.w); q.z = pk2(b.x, b.y); q.w = pk2(b.z, b.w);
            o[64 * j] = q;
            if (w8) { const f32x4 a8 = a * G8_ASCALE, b8 = b * G8_ASCALE; o8[64 * j] = (v2u){pk4f8(a8.x, a8.y, a8.z, a8.w), pk4f8(b8.x, b8.y, b8.z, b8.w)}; }
        }
    }
}

DI void ph_final(Frame& F) {
    const Params& p = F.p;
    const int gw = F.bid * NWAVES + F.wave, NGW = F.G * NWAVES;
    for (int r = gw; r < NB * SEQ; r += NGW) {
        float* h = p.out + (size_t)r * DM;
        const bf16* yr = (const bf16*)(F.ws + WS_Y) + ((size_t)(r / SEQ) * TPB + 128 + (r % SEQ)) * DM;
        f32x4 v[8]; float s = 0.f;
#pragma unroll
        for (int j = 0; j < 4; ++j) { const v4u t = *(const v4u*)(yr + 512 * j + 8 * F.lane); v[2 * j] = *(const f32x4*)(h + 512 * j + 8 * F.lane) + (f32x4){bflo(t.x), bfhi(t.x), bflo(t.y), bfhi(t.y)}; v[2 * j + 1] = *(const f32x4*)(h + 512 * j + 8 * F.lane + 4) + (f32x4){bflo(t.z), bfhi(t.z), bflo(t.w), bfhi(t.w)}; }
#pragma unroll
        for (int j = 0; j < 8; ++j) s += (v[j].x * v[j].x + v[j].y * v[j].y) + (v[j].z * v[j].z + v[j].w * v[j].w);
        const float rstd = rsqrtf(wave_sum(s) * (1.f / DM) + EPS);
#pragma unroll
        for (int j = 0; j < 4; ++j) {
            const f32x4 w0 = *(const f32x4*)(p.final_norm_w + 512 * j + 8 * F.lane), w1 = *(const f32x4*)(p.final_norm_w + 512 * j + 8 * F.lane + 4);
            *(f32x4*)(h + 512 * j + 8 * F.lane) = v[2 * j] * rstd * w0; *(f32x4*)(h + 512 * j + 8 * F.lane + 4) = v[2 * j + 1] * rstd * w1;
        }
    }
}

typedef pg8::Unit Unit;
#define EPI_ROWS(ai, m) (u.pm * 256 + (ai) * 128 + wr * 64 + (m) * 16 + fr)
#define EPI_COL8(bj) ((bj) * 128 + wc * 32 + 8 * fq)
DI v4u pack8(const f32x4& a, const f32x4& b) { v4u w; w.x = pk2(a.x, a.y); w.y = pk2(a.z, a.w); w.z = pk2(b.x, b.y); w.w = pk2(b.z, b.w); return w; }

struct EpiInA {
    unsigned char* ws;
    DI void operator()(const f32x4 (&acc)[2][2][4][2], const Unit& u, int wr, int wc, int fr, int fq) const {
        const int t = u.pn;
        if (t < 34) {
            size_t off; int ld, coff;
            if (t < 4) { off = WS_Z; ld = 1024; coff = t * 256; }
            else if (t < 10) { off = WS_XBC; ld = 1536; coff = (t - 4) * 256; }
            else if (t < 12) { off = WS_MQ; ld = 512; coff = (t - 10) * 256; }
            else if (t < 14) { off = WS_MK; ld = 512; coff = (t - 12) * 256; }
            else if (t < 18) { off = WS_MV; ld = 1024; coff = (t - 14) * 256; }
            else if (t < 22) { off = WS_MO; ld = 1024; coff = (t - 18) * 256; }
            else if (t < 26) { off = WS_AQ; ld = 1024; coff = (t - 22) * 256; }
            else if (t < 30) { off = WS_AK; ld = 1024; coff = (t - 26) * 256; }
            else { off = WS_AV; ld = 1024; coff = (t - 30) * 256; }
            bf16* dst = (bf16*)(ws + off) + coff;
#pragma unroll
            for (int ai = 0; ai < 2; ++ai)
#pragma unroll
                for (int m = 0; m < 4; ++m) { bf16* rowp = dst + (size_t)EPI_ROWS(ai, m) * ld;
#pragma unroll
                    for (int bj = 0; bj < 2; ++bj) *(v4u*)(rowp + EPI_COL8(bj)) = pack8(acc[ai][bj][m][0], acc[ai][bj][m][1]);
                    asm volatile("" ::: "memory"); }
        } else {
            float* SM = (float*)(ws + WS_SMALL);
            if (wc == 0 && fq < 3) {
#pragma unroll
                for (int ai = 0; ai < 2; ++ai)
#pragma unroll
                    for (int m = 0; m < 4; ++m) { float* d = SM + (size_t)EPI_ROWS(ai, m) * 32 + 8 * fq; *(f32x4*)d = acc[ai][0][m][0]; *(f32x4*)(d + 4) = acc[ai][0][m][1]; }
            }
        }
    }
};

DI unsigned pk4u8(const f32x4& v) { return (unsigned)__builtin_rintf(v.x * 255.f) | ((unsigned)__builtin_rintf(v.y * 255.f) << 8) | ((unsigned)__builtin_rintf(v.z * 255.f) << 16) | ((unsigned)__builtin_rintf(v.w * 255.f) << 24); }
struct EpiGates {
    unsigned char* G;
    static DI float sg(float x) { return __builtin_amdgcn_rcpf(1.f + __builtin_amdgcn_exp2f(x * (-1.4426950408889634f / (G8_ASCALE * G8_BSCALE)))); }
    DI void operator()(const f32x4 (&acc)[2][2][4][2], const Unit& u, int wr, int wc, int fr, int fq) const {
#pragma unroll
        for (int ai = 0; ai < 2; ++ai)
#pragma unroll
            for (int m = 0; m < 4; ++m) { unsigned char* rowp = G + (size_t)EPI_ROWS(ai, m) * NG_COLS + u.pn * 256;
#pragma unroll
                for (int bj = 0; bj < 2; ++bj) { f32x4 v0 = acc[ai][bj][m][0], v1 = acc[ai][bj][m][1];
                    v0 = (f32x4){sg(v0.x), sg(v0.y), sg(v0.z), sg(v0.w)}; v1 = (f32x4){sg(v1.x), sg(v1.y), sg(v1.z), sg(v1.w)};
                    *(v2u*)(rowp + EPI_COL8(bj)) = (v2u){pk4u8(v0), pk4u8(v1)}; } asm volatile("" ::: "memory"); }
    }
};

template <int BR> struct EpiMerge {
    const unsigned char* G; bf16* Mg; const float* ssq;
    DI void operator()(const f32x4 (&acc)[2][2][4][2], const Unit& u, int wr, int wc, int fr, int fq) const {
#pragma unroll
        for (int ai = 0; ai < 2; ++ai)
#pragma unroll
            for (int m = 0; m < 4; ++m) { const int row = EPI_ROWS(ai, m); const unsigned char* grow = G + (size_t)row * NG_COLS + BR * 2048 + u.pn * 256; bf16* mrow = Mg + (size_t)row * DM + u.pn * 256;
                float rs = 1.f / 255.f;
                if (BR == 0) rs = ssq[row] * (1.f / 255.f);
#pragma unroll
                for (int bj = 0; bj < 2; ++bj) { const int c = EPI_COL8(bj);
                    const v2u gw = *(const v2u*)(grow + c);
                    f32x4 v0 = acc[ai][bj][m][0] * rs, v1 = acc[ai][bj][m][1] * rs;
                    v0 = v0 * (f32x4){(float)(gw.x & 255u), (float)((gw.x >> 8) & 255u), (float)((gw.x >> 16) & 255u), (float)(gw.x >> 24)}; v1 = v1 * (f32x4){(float)(gw.y & 255u), (float)((gw.y >> 8) & 255u), (float)((gw.y >> 16) & 255u), (float)(gw.y >> 24)};
                    if (BR != 0) { const v4u ow = *(const v4u*)(mrow + c);
                        v0 = v0 + (f32x4){bflo(ow.x), bfhi(ow.x), bflo(ow.y), bfhi(ow.y)}; v1 = v1 + (f32x4){bflo(ow.z), bfhi(ow.z), bflo(ow.w), bfhi(ow.w)}; }
                    *(v4u*)(mrow + c) = pack8(v0, v1); } asm volatile("" ::: "memory"); }
    }
};

struct EpiResid {
    const Params& p; unsigned char* ws;
    DI void operator()(const f32x4 (&acc)[2][2][4][2], const Unit& u, int wr, int wc, int fr, int fq) const {
#pragma unroll
        for (int ai = 0; ai < 2; ++ai)
#pragma unroll
            for (int m = 0; m < 4; ++m) { float* h = hrow(p, ws, EPI_ROWS(ai, m)); if (!h) continue; h += u.pn * 256;
#pragma unroll
                for (int bj = 0; bj < 2; ++bj) { float* d = h + EPI_COL8(bj); *(f32x4*)d = *(const f32x4*)d + acc[ai][bj][m][0]; *(f32x4*)(d + 4) = *(const f32x4*)(d + 4) + acc[ai][bj][m][1]; } asm volatile("" ::: "memory"); }
    }
};

struct EpiBf16 {
    bf16* O; int ld;
    DI void operator()(const f32x4 (&acc)[2][2][4][2], const Unit& u, int wr, int wc, int fr, int fq) const {
#pragma unroll
        for (int ai = 0; ai < 2; ++ai)
#pragma unroll
            for (int m = 0; m < 4; ++m) { bf16* rowp = O + (size_t)EPI_ROWS(ai, m) * ld + u.pn * 256;
#pragma unroll
                for (int bj = 0; bj < 2; ++bj) *(v4u*)(rowp + EPI_COL8(bj)) = pack8(acc[ai][bj][m][0], acc[ai][bj][m][1]); asm volatile("" ::: "memory"); }
    }
};
struct EpiF32 {
    float* O; int ld;
    DI void operator()(const f32x4 (&acc)[2][2][4][2], const Unit& u, int wr, int wc, int fr, int fq) const {
#pragma unroll
        for (int ai = 0; ai < 2; ++ai)
#pragma unroll
            for (int m = 0; m < 4; ++m) { float* rowp = O + (size_t)EPI_ROWS(ai, m) * ld + u.pn * 256;
#pragma unroll
                for (int bj = 0; bj < 2; ++bj) { float* d = rowp + EPI_COL8(bj); *(f32x4*)d = acc[ai][bj][m][0]; *(f32x4*)(d + 4) = acc[ai][bj][m][1]; } asm volatile("" ::: "memory"); }
    }
};

DI float row16_sum(float v) {
    v += __builtin_bit_cast(float, __builtin_amdgcn_update_dpp(0, __builtin_bit_cast(int, v), 0x128, 0xf, 0xf, false));
    v += __builtin_bit_cast(float, __builtin_amdgcn_update_dpp(0, __builtin_bit_cast(int, v), 0x124, 0xf, 0xf, false));
    v += __builtin_bit_cast(float, __builtin_amdgcn_update_dpp(0, __builtin_bit_cast(int, v), 0x122, 0xf, 0xf, false));
    v += __builtin_bit_cast(float, __builtin_amdgcn_update_dpp(0, __builtin_bit_cast(int, v), 0x121, 0xf, 0xf, false));
    return v;
}
DI float softplusf_(float x) { return x > 20.f ? x : log1pf(__expf(x)); }

DI void ph_conv(Frame& F, int layer) {
    const Params& p = F.p;
    const bf16* XBC = (const bf16*)(F.ws + WS_XBC); bf16* XCX = (bf16*)(F.ws + WS_XCX); bf16* XCB = (bf16*)(F.ws + WS_XCB);
    const float* cw = p.conv_w + (size_t)layer * 4 * 1536; const float* cb = p.conv_b + (size_t)layer * 1536;
    const int gt = F.bid * 512 + F.tid, NT = F.G * 512;
    for (int it = gt; it < TP * 192; it += NT) {
        const int r = it / 192, gi = it - r * 192, ch0 = 8 * gi; const int b = r / TPB, q = r - b * TPB;
        v4u o = (v4u){0u, 0u, 0u, 0u};
        if (q >= PADR) {
            float a[8];
            { const f32x4 b0 = *(const f32x4*)(cb + ch0), b1 = *(const f32x4*)(cb + ch0 + 4); a[0] = b0.x; a[1] = b0.y; a[2] = b0.z; a[3] = b0.w; a[4] = b1.x; a[5] = b1.y; a[6] = b1.z; a[7] = b1.w; }
#pragma unroll
            for (int j = 0; j < 4; ++j) {
                const v4u x = *(const v4u*)(XBC + (size_t)(r - 3 + j) * 1536 + ch0);
                const f32x4 w0 = *(const f32x4*)(cw + j * 1536 + ch0), w1 = *(const f32x4*)(cw + j * 1536 + ch0 + 4);
                a[0] += w0.x * bflo(x.x); a[1] += w0.y * bfhi(x.x); a[2] += w0.z * bflo(x.y); a[3] += w0.w * bfhi(x.y);
                a[4] += w1.x * bflo(x.z); a[5] += w1.y * bfhi(x.z); a[6] += w1.z * bflo(x.w); a[7] += w1.w * bfhi(x.w);
            }
            o.x = pk2(siluf_(a[0]), siluf_(a[1])); o.y = pk2(siluf_(a[2]), siluf_(a[3])); o.z = pk2(siluf_(a[4]), siluf_(a[5])); o.w = pk2(siluf_(a[6]), siluf_(a[7]));
        }
        if (ch0 < 1024) *(v4u*)(XCX + (size_t)r * 1024 + ch0) = o; else *(v4u*)(XCB + (size_t)r * 512 + (ch0 - 1024)) = o;
    }
}

constexpr int DL_RS = 136;
constexpr int DL_Q = 0, DL_K = 128 * DL_RS * 2, DL_KT = 2 * DL_K, DL_VT = 3 * DL_K, DL_SB = DL_VT + 80 * DL_RS * 2, DL_SC = DL_SB + 80 * DL_RS * 2;
static_assert(DL_SC + 8 * 512 + 64 <= LDSCTL_OFF, "DLA LDS map");
#define MFMA16(a, b, c) __builtin_amdgcn_mfma_f32_16x16x32_bf16((a), (b), (c), 0, 0, 0)
DI bf16x8 dl_frag(const LAS bf16* base, int row, int k0) { return *(const LAS bf16x8*)(base + row * DL_RS + k0); }

template <bool ML>
DI void dla_unit(Frame& F, int unit, int layer) {
    const Params& p = F.p;
    constexpr int NV = ML ? 5 : 4;
    const int tid = F.tid, lane = F.lane, w = F.wave, fr = lane & 15, fq = lane >> 4;
    const int b = unit >> 4, hh = ML ? ((unit >> 2) & 3) : (unit & 15), vq = unit & 3;
    const bf16* Qg; const bf16* Kg; const bf16* Vg;
    if (ML) { Qg = (const bf16*)(F.ws + WS_MQ) + hh * 128; Kg = (const bf16*)(F.ws + WS_MK) + hh * 128; Vg = (const bf16*)(F.ws + WS_MV) + hh * 256 + vq * 64; }
    else { Qg = (const bf16*)(F.ws + WS_XCB) + 256 + (hh >> 3) * 128; Kg = (const bf16*)(F.ws + WS_XCB) + (hh >> 3) * 128; Vg = (const bf16*)(F.ws + WS_XCX) + hh * 64; }
    LAS bf16* Qs = (LAS bf16*)(F.lds + DL_Q); LAS bf16* Ks = (LAS bf16*)(F.lds + DL_K); LAS bf16* KT = (LAS bf16*)(F.lds + DL_KT); LAS bf16* Gs = KT;
    LAS bf16* VT = (LAS bf16*)(F.lds + DL_VT); LAS bf16* Sb = (LAS bf16*)(F.lds + DL_SB);
    LAS float* g_ = (LAS float*)(F.lds + DL_SC); LAS float* cs_ = g_ + 128; LAS float* rq_ = cs_ + 128; LAS float* wg_ = rq_ + 128; LAS float* in_ = wg_ + 128; LAS float* em_ = in_ + 128; LAS float* dt_ = em_ + 128; LAS float* sc_ = dt_ + 128;
    const float* SM = (const float*)(F.ws + WS_SMALL);
    float c_a, c_b, c_d;
    if (ML) { c_a = p.i_bias[layer * 4 + hh]; c_b = p.f_bias[layer * 4 + hh]; c_d = 0.f; }
    else { c_a = p.dt_bias[layer * 16 + hh]; c_b = -__expf(p.a_log[layer * 16 + hh]); c_d = p.ssd_d[layer * 16 + hh]; }
    f32x4 St[NV];
#pragma unroll
    for (int t = 0; t < NV; ++t) St[t] = (f32x4){0.f, 0.f, 0.f, 0.f};
    for (int i = tid; i < 80 * DL_RS / 8; i += 512) ((LAS v4u*)Sb)[i] = (v4u){0u, 0u, 0u, 0u};
    for (int i = tid; i < 16 * DL_RS / 8; i += 512) { const unsigned one2 = (ML && i < DL_RS / 8) ? 0x3F803F80u : 0u; ((LAS v4u*)(VT + 64 * DL_RS))[i] = (v4u){one2, one2, one2, one2}; }
    if (tid == 0) sc_[1] = -1e30f;
    v4u qreg[4], kreg[4], vreg[2];
    const int vs_ = tid & 127, vc_ = tid >> 7;
#define DL_LOAD(c) do { const size_t r0_ = (size_t)b * TPB + 128 * (c); \
        _Pragma("unroll") for (int j = 0; j < 4; ++j) { const int idx = tid + 512 * j, rr = idx >> 4, ch = idx & 15; qreg[j] = *(const v4u*)(Qg + (r0_ + rr) * 512 + 8 * ch); kreg[j] = *(const v4u*)(Kg + (r0_ + rr) * 512 + 8 * ch); } \
        _Pragma("unroll") for (int j = 0; j < 2; ++j) vreg[j] = *(const v4u*)(Vg + (r0_ + vs_) * 1024 + 8 * (vc_ + 4 * j)); } while (0)
    DL_LOAD(0);
    __syncthreads();
    for (int c = 0; c < TPB / 128; ++c) {
        const size_t row0 = (size_t)b * TPB + 128 * c;
        if (w == 0) {
            const int l0 = 2 * lane; const bool r0 = (128 * c + l0) >= PADR, r1 = (128 * c + l0 + 1) >= PADR;
            float ld0, ld1, x0 = 0.f, x1 = 0.f, d0 = 0.f, d1 = 0.f;
            if (ML) {
                const float f0 = SM[(row0 + l0) * 32 + 20 + hh] + c_b, f1 = SM[(row0 + l0 + 1) * 32 + 20 + hh] + c_b;
                ld0 = r0 ? (fminf(f0, 0.f) - log1pf(__expf(-fabsf(f0)))) : 0.f; ld1 = r1 ? (fminf(f1, 0.f) - log1pf(__expf(-fabsf(f1)))) : 0.f;
                x0 = r0 ? (SM[(row0 + l0) * 32 + 16 + hh] + c_a) : -1e30f; x1 = r1 ? (SM[(row0 + l0 + 1) * 32 + 16 + hh] + c_a) : -1e30f;
            } else {
                d0 = r0 ? softplusf_(SM[(row0 + l0) * 32 + hh] + c_a) : 0.f; d1 = r1 ? softplusf_(SM[(row0 + l0 + 1) * 32 + hh] + c_a) : 0.f;
                ld0 = d0 * c_b; ld1 = d1 * c_b;
            }
            float run = ld0 + ld1;
#pragma unroll
            for (int o = 1; o < 64; o <<= 1) { const float y = __shfl_up(run, o); if (lane >= o) run += y; }
            const float g1 = run, g0 = run - ld1, gtot = __shfl(run, 63);
            if (ML) {
                const float mprev = sc_[1];
                const float cs0 = x0 - g0, cs1 = x1 - g1;
                float pm1 = fmaxf(cs0, cs1);
#pragma unroll
                for (int o = 1; o < 64; o <<= 1) { const float y = __shfl_up(pm1, o); if (lane >= o) pm1 = fmaxf(pm1, y); }
                float pm0 = __shfl_up(pm1, 1); pm0 = (lane == 0) ? cs0 : fmaxf(pm0, cs0);
                const float M0 = fmaxf(pm0, mprev), M1 = fmaxf(pm1, mprev), Ml = __shfl(M1, 63);
                g_[l0] = g0; g_[l0 + 1] = g1; cs_[l0] = cs0; cs_[l0 + 1] = cs1; rq_[l0] = -M0; rq_[l0 + 1] = -M1;
                in_[l0] = __expf(mprev - M0); in_[l0 + 1] = __expf(mprev - M1);
                em_[l0] = r0 ? __expf(-(g0 + M0)) : 1.f; em_[l0 + 1] = r1 ? __expf(-(g1 + M1)) : 1.f;
                wg_[l0] = __expf(cs0 - Ml); wg_[l0 + 1] = __expf(cs1 - Ml);
                if (lane == 0) { sc_[0] = __expf(mprev - Ml); sc_[1] = gtot + Ml; }
            } else {
                g_[l0] = g0; g_[l0 + 1] = g1; cs_[l0] = -g0; cs_[l0 + 1] = -g1; rq_[l0] = g0; rq_[l0 + 1] = g1;
                in_[l0] = __expf(g0); in_[l0 + 1] = __expf(g1); wg_[l0] = __expf(gtot - g0); wg_[l0 + 1] = __expf(gtot - g1);
                dt_[l0] = d0; dt_[l0 + 1] = d1;
                if (lane == 0) sc_[0] = __expf(gtot);
            }
        }
        __syncthreads();
#pragma unroll
        for (int j = 0; j < 4; ++j) { const int idx = tid + 512 * j, rr = idx >> 4, ch = idx & 15; *(LAS v4u*)(Qs + rr * DL_RS + 8 * ch) = qreg[j]; *(LAS v4u*)(Ks + rr * DL_RS + 8 * ch) = kreg[j]; }
        { const float dsc = ML ? 1.f : dt_[vs_];
#pragma unroll
          for (int j = 0; j < 2; ++j) { LAS bf16* d = VT + (8 * (vc_ + 4 * j)) * DL_RS + vs_; const v4u x = vreg[j];
              d[0 * DL_RS] = (bf16)f2bf(bflo(x.x) * dsc); d[1 * DL_RS] = (bf16)f2bf(bfhi(x.x) * dsc); d[2 * DL_RS] = (bf16)f2bf(bflo(x.y) * dsc); d[3 * DL_RS] = (bf16)f2bf(bfhi(x.y) * dsc);
              d[4 * DL_RS] = (bf16)f2bf(bflo(x.z) * dsc); d[5 * DL_RS] = (bf16)f2bf(bfhi(x.z) * dsc); d[6 * DL_RS] = (bf16)f2bf(bflo(x.w) * dsc); d[7 * DL_RS] = (bf16)f2bf(bfhi(x.w) * dsc); } }
        __syncthreads();
        { const int s_ = tid & 127, cg = tid >> 7; const float ws = wg_[s_];
#pragma unroll
          for (int c4 = 0; c4 < 4; ++c4) { const int ch = 4 * cg + c4; const v4u x = *(const LAS v4u*)(Ks + s_ * DL_RS + 8 * ch); LAS bf16* d = KT + (8 * ch) * DL_RS + s_;
              d[0 * DL_RS] = (bf16)f2bf(bflo(x.x) * ws); d[1 * DL_RS] = (bf16)f2bf(bfhi(x.x) * ws); d[2 * DL_RS] = (bf16)f2bf(bflo(x.y) * ws); d[3 * DL_RS] = (bf16)f2bf(bfhi(x.y) * ws);
              d[4 * DL_RS] = (bf16)f2bf(bflo(x.z) * ws); d[5 * DL_RS] = (bf16)f2bf(bfhi(x.z) * ws); d[6 * DL_RS] = (bf16)f2bf(bflo(x.w) * ws); d[7 * DL_RS] = (bf16)f2bf(bfhi(x.w) * ws); } }
        f32x4 Y[NV];
#pragma unroll
        for (int t = 0; t < NV; ++t) Y[t] = (f32x4){0.f, 0.f, 0.f, 0.f};
#pragma unroll
        for (int ks = 0; ks < 4; ++ks) { const bf16x8 a = dl_frag(Qs, 16 * w + fr, 32 * ks + 8 * fq);
#pragma unroll
            for (int t = 0; t < NV; ++t) Y[t] = MFMA16(a, dl_frag(Sb, 16 * t + fr, 32 * ks + 8 * fq), Y[t]); }
        __syncthreads();
        { const float dec = sc_[0];
#pragma unroll
          for (int t = 0; t < NV; ++t) St[t] = St[t] * dec;
#pragma unroll
          for (int ks = 0; ks < 4; ++ks) { const bf16x8 bb = dl_frag(KT, 16 * w + fr, 32 * ks + 8 * fq);
#pragma unroll
              for (int t = 0; t < NV; ++t) St[t] = MFMA16(dl_frag(VT, 16 * t + fr, 32 * ks + 8 * fq), bb, St[t]); }
#pragma unroll
          for (int t = 0; t < NV; ++t) { LAS bf16* d = Sb + (16 * t + 4 * fq) * DL_RS + 16 * w + fr;
              d[0 * DL_RS] = (bf16)f2bf(St[t].x); d[1 * DL_RS] = (bf16)f2bf(St[t].y); d[2 * DL_RS] = (bf16)f2bf(St[t].z); d[3 * DL_RS] = (bf16)f2bf(St[t].w); } }
        if (c + 1 < TPB / 128) DL_LOAD(c + 1);
        __syncthreads();
        {
            float rq[4], inr[4];
#pragma unroll
            for (int i = 0; i < 4; ++i) { rq[i] = rq_[16 * w + 4 * fq + i]; inr[i] = in_[16 * w + 4 * fq + i]; }
#pragma unroll
            for (int ct = 0; ct < 8; ++ct) {
                if (ct <= (w | 1)) {
                    f32x4 sc = (f32x4){0.f, 0.f, 0.f, 0.f};
                    if (ct <= w) {
#pragma unroll
                        for (int ks = 0; ks < 4; ++ks) sc = MFMA16(dl_frag(Qs, 16 * w + fr, 32 * ks + 8 * fq), dl_frag(Ks, 16 * ct + fr, 32 * ks + 8 * fq), sc);
                        const float cs = cs_[16 * ct + fr]; const int scol = 16 * ct + fr;
#pragma unroll
                        for (int i = 0; i < 4; ++i) { const int lr = 16 * w + 4 * fq + i; const float wt = (scol <= lr) ? __expf(rq[i] + cs) : 0.f; sc[i] = sc[i] * wt; }
                    }
                    LAS bf16* d = Gs + (16 * w + 4 * fq) * DL_RS + 16 * ct + fr;
                    d[0 * DL_RS] = (bf16)f2bf(sc.x); d[1 * DL_RS] = (bf16)f2bf(sc.y); d[2 * DL_RS] = (bf16)f2bf(sc.z); d[3 * DL_RS] = (bf16)f2bf(sc.w);
                }
            }
#pragma unroll
            for (int t = 0; t < NV; ++t) { Y[t].x *= inr[0]; Y[t].y *= inr[1]; Y[t].z *= inr[2]; Y[t].w *= inr[3]; }
#pragma unroll
            for (int ks = 0; ks < 4; ++ks) {
                if (2 * ks <= w) { const bf16x8 a = dl_frag(Gs, 16 * w + fr, 32 * ks + 8 * fq);
#pragma unroll
                    for (int t = 0; t < NV; ++t) Y[t] = MFMA16(a, dl_frag(VT, 16 * t + fr, 32 * ks + 8 * fq), Y[t]); }
            }
        }
        if (ML) {
            bf16* MVo = (bf16*)(F.ws + WS_MV) + hh * 256 + vq * 64; float* SSQM = (float*)(F.ws + WS_SSQM);
#pragma unroll
            for (int i = 0; i < 4; ++i) { const int lr = 16 * w + 4 * fq + i; const bool real = (128 * c + lr) >= PADR;
                float dn = (fr == 0) ? Y[NV - 1][i] : 0.f; dn = row16_sum(dn);
                const float den = fmaxf(fabsf(dn), em_[lr]); const float rden = 1.f / den; float ss = 0.f;
#pragma unroll
                for (int t = 0; t < 4; ++t) { const float hv = Y[t][i] * rden; ss += hv * hv; if (real) MVo[(row0 + lr) * 1024 + 16 * t + fr] = (bf16)f2bf(hv); }
                ss = row16_sum(ss);
                if (fr == 0 && real) SSQM[(row0 + lr) * 32 + hh * 4 + vq] = ss; }
        } else {
            bf16* Zo = (bf16*)(F.ws + WS_Z) + hh * 64; const bf16* Xo = (const bf16*)(F.ws + WS_XCX) + hh * 64; float* SSQ = (float*)(F.ws + WS_SSQ);
#pragma unroll
            for (int i = 0; i < 4; ++i) { const int lr = 16 * w + 4 * fq + i; const bool real = (128 * c + lr) >= PADR; float ss = 0.f;
                if (real) {
#pragma unroll
                    for (int t = 0; t < 4; ++t) { const size_t off = (row0 + lr) * 1024 + 16 * t + fr;
                        const float xs = __builtin_bit_cast(float, (unsigned)Xo[off] << 16), zz = __builtin_bit_cast(float, (unsigned)Zo[off] << 16);
                        const float yv = (Y[t][i] + c_d * xs) * siluf_(zz); ss += yv * yv; Zo[off] = (bf16)f2bf(yv); } }
                ss = row16_sum(ss);
                if (fr == 0 && real) SSQ[(row0 + lr) * 32 + hh] = ss; }
        }
        __syncthreads();
    }
#undef DL_LOAD
}

DI void ph_mlfinal(Frame& F, int layer) {
    const Params& p = F.p;
    const bf16* MV = (const bf16*)(F.ws + WS_MV); bf16* MO = (bf16*)(F.ws + WS_MO); const float* SSQM = (const float*)(F.ws + WS_SSQM);
    const float* w = p.ml_norm_w + layer * 1024;
    const int gw = F.bid * NWAVES + F.wave, NGW = F.G * NWAVES;
    for (int r = gw; r < TP; r += NGW) {
        const int b = r / TPB, q = r - b * TPB; if (q < PADR) { if (F.lane == 0) ((float*)(F.ws + WS_RSTD))[r] = 0.f; continue; }
        { const float sp = (F.lane < 16) ? ((const float*)(F.ws + WS_SSQ))[(size_t)r * 32 + F.lane] : 0.f; const float tot = wave_sum(sp);
          if (F.lane == 0) ((float*)(F.ws + WS_RSTD))[r] = rsqrtf(tot * (1.f / 1024.f) + EPS); }
        const int hd = F.lane >> 4;
        const f32x4 s0 = *(const f32x4*)(SSQM + (size_t)r * 32 + hd * 4);
        const float rstd = rsqrtf(((s0.x + s0.y) + (s0.z + s0.w)) * (1.f / 256.f) + EPS);
#pragma unroll
        for (int j = 0; j < 2; ++j) {
            const size_t off = (size_t)r * 1024 + 16 * F.lane + 8 * j;
            const v4u hv = *(const v4u*)(MV + off), ov = *(const v4u*)(MO + off);
            const f32x4 w0 = *(const f32x4*)(w + 16 * F.lane + 8 * j), w1 = *(const f32x4*)(w + 16 * F.lane + 8 * j + 4);
            const f32x4 a = (f32x4){bflo(hv.x), bfhi(hv.x), bflo(hv.y), bfhi(hv.y)} * (f32x4){sigmoidf_(bflo(ov.x)), sigmoidf_(bfhi(ov.x)), sigmoidf_(bflo(ov.y)), sigmoidf_(bfhi(ov.y))} * w0 * rstd;
            const f32x4 c = (f32x4){bflo(hv.z), bfhi(hv.z), bflo(hv.w), bfhi(hv.w)} * (f32x4){sigmoidf_(bflo(ov.z)), sigmoidf_(bfhi(ov.z)), sigmoidf_(bflo(ov.w)), sigmoidf_(bfhi(ov.w))} * w1 * rstd;
            *(v4u*)(MO + off) = pack8(a, c);
        }
    }
}


DI void ph_rope_apply(Frame& F) {
    const Params& p = F.p;
    const float* tab = (const float*)(F.ws + WS_ROPE);
    const int gw = F.bid * NWAVES + F.wave, NGW = F.G * NWAVES, lane = F.lane;
    bf16* T = (bf16*)(F.ws + ((lane >> 5) ? WS_AK : WS_AQ));
    const int grp = (lane >> 1) & 15, half = lane & 1;
    for (int r = gw; r < TP; r += NGW) {
        const int b = r / TPB, q = r - b * TPB; if (q < PADR) continue;
        const f32x4 c = *(const f32x4*)(tab + (size_t)r * 16 + 4 * half), sn = *(const f32x4*)(tab + (size_t)r * 16 + 8 + 4 * half);
        bf16* base = T + (size_t)r * 1024 + grp * 64 + 4 * half;
        const v2u w1 = *(const v2u*)base, w2 = *(const v2u*)(base + 8);
        const f32x4 t1 = (f32x4){bflo(w1.x), bfhi(w1.x), bflo(w1.y), bfhi(w1.y)}, t2 = (f32x4){bflo(w2.x), bfhi(w2.x), bflo(w2.y), bfhi(w2.y)};
        const f32x4 o1 = t1 * c - t2 * sn, o2 = t2 * c + t1 * sn;
        v2u a, d; a.x = pk2(o1.x, o1.y); a.y = pk2(o1.z, o1.w); d.x = pk2(o2.x, o2.y); d.y = pk2(o2.z, o2.w);
        *(v2u*)base = a; *(v2u*)(base + 8) = d;
    }
}
DI void ph_vtranspose(Frame& F) {
    const Params& p = F.p;
    const bf16* AV = (const bf16*)(F.ws + WS_AV); bf16* VT = (bf16*)(F.ws + WS_VT);
    LAS bf16* tile = (LAS bf16*)F.lds;
    const int tid = F.tid;
    constexpr int NT = NB * (TPB / 64) * 8;
    for (int t = F.bid; t < NT; t += F.G) {
        const int head = t & 7, rb = (t >> 3) % (TPB / 64), b = (t >> 3) / (TPB / 64);
        { const int l = tid >> 3, c16 = tid & 7;
          const bf16* src = AV + ((size_t)b * TPB + rb * 64 + l) * 1024 + head * 128 + 16 * c16;
          const v4u x0 = *(const v4u*)src, x1 = *(const v4u*)(src + 8);
          LAS bf16* d = tile + (16 * c16) * 72 + l;
          d[0 * 72] = (bf16)(x0.x & 0xffff); d[1 * 72] = (bf16)(x0.x >> 16); d[2 * 72] = (bf16)(x0.y & 0xffff); d[3 * 72] = (bf16)(x0.y >> 16);
          d[4 * 72] = (bf16)(x0.z & 0xffff); d[5 * 72] = (bf16)(x0.z >> 16); d[6 * 72] = (bf16)(x0.w & 0xffff); d[7 * 72] = (bf16)(x0.w >> 16);
          d[8 * 72] = (bf16)(x1.x & 0xffff); d[9 * 72] = (bf16)(x1.x >> 16); d[10 * 72] = (bf16)(x1.y & 0xffff); d[11 * 72] = (bf16)(x1.y >> 16);
          d[12 * 72] = (bf16)(x1.z & 0xffff); d[13 * 72] = (bf16)(x1.z >> 16); d[14 * 72] = (bf16)(x1.w & 0xffff); d[15 * 72] = (bf16)(x1.w >> 16); }
        __syncthreads();
        { const int dv = tid >> 2, seg = tid & 3;
          const LAS bf16* sp = tile + dv * 72 + 16 * seg;
          const v4u y0 = *(const LAS v4u*)sp, y1 = *(const LAS v4u*)(sp + 8);
          bf16* dst = VT + ((size_t)(b * 8 + head) * 128 + dv) * TPB + rb * 64 + 16 * seg;
          *(v4u*)dst = y0; *(v4u*)(dst + 8) = y1; }
        __syncthreads();
    }
}

DI unsigned cvtpk_s(float lo, float hi) { return pk2(lo, hi); }
DI float max3f_(float a, float b, float c) { float r; asm("v_max3_f32 %0, %1, %2, %3" : "=v"(r) : "v"(a), "v"(b), "v"(c)); return r; }
DI int crow(int r, int hi) { return (r & 3) + 8 * (r >> 2) + 4 * hi; }
#define MFMA32(a, b, c) __builtin_amdgcn_mfma_f32_32x32x16_bf16((a), (b), (c), 0, 0, 0)
constexpr int AT_STAGE = 32768, AT_KM = 8192, AT_V = 16384;
DI void glds16(const void* gsrc, unsigned lds_dst) { unsigned keep; asm volatile("s_mov_b32 %0, m0\n\ts_mov_b32 m0, %2\n\ts_nop 0\n\tglobal_load_lds_dwordx4 %1, off\n\ts_mov_b32 m0, %0" : "=&s"(keep) : "v"(gsrc), "s"(lds_dst) : "memory"); }

DI void attn_unit(Frame& F, int b, int head, int qb, int layer) {
    const Params& p = F.p;
    const int lane = F.lane, w = F.wave, map = w >> 2, qg = w & 3, r = lane & 31, hh = lane >> 5;
    bf16* AQ = (bf16*)(F.ws + WS_AQ); const bf16* AK = (const bf16*)(F.ws + WS_AK); const bf16* VT = (const bf16*)(F.ws + WS_VT);
    const int qw0 = 128 * qb + 32 * qg;
    const size_t rowb = (size_t)b * TPB;
    bf16x8 qf[4];
    { const bf16* qp = AQ + (rowb + qw0 + r) * 1024 + head * 128 + map * 64 + 8 * hh;
#pragma unroll
        for (int s = 0; s < 4; ++s) qf[s] = *(const bf16x8*)(qp + 16 * s); }
    f32x16 O[4];
#pragma unroll
    for (int d = 0; d < 4; ++d)
#pragma unroll
        for (int i = 0; i < 16; ++i) O[d][i] = 0.f;
    float mrun = -1e30f, lrun = 0.f;
    const int tlast = 2 * qb + 1;
    const bf16* src[4]; unsigned dst[4];
    const unsigned lds0 = (unsigned)(uintptr_t)F.lds;
#pragma unroll
    for (int i = 0; i < 4; ++i) {
        const int pc = 4 * w + i, rin = lane >> 3;
        if (pc < 16) { const int km = pc >> 3, R = 8 * (pc & 7) + rin, m5 = R & 31, dc = (lane & 7) ^ ((R >> 1) & 7), key = (R & 32) + ((m5 & ~12) | ((m5 & 4) << 1) | ((m5 & 8) >> 1));
            src[i] = AK + (rowb + key) * 1024 + head * 128 + km * 64 + 8 * dc; dst[i] = lds0 + km * AT_KM + (pc & 7) * 1024; }
        else { const int R = 8 * (pc - 16) + rin, dc = (lane & 7) ^ ((R >> 1) & 7);
            src[i] = VT + ((size_t)(b * 8 + head) * 128 + R) * TPB + 8 * dc; dst[i] = lds0 + AT_V + (pc - 16) * 1024; }
    }
    const bool isk = w < 4;
#define AT_DMA(t, stg) do { const size_t go = isk ? (size_t)(t) * 64 * 1024 : (size_t)(t) * 64; \
        _Pragma("unroll") for (int i = 0; i < 4; ++i) glds16(src[i] + go, (unsigned)__builtin_amdgcn_readfirstlane(dst[i] + (stg) * AT_STAGE)); } while (0)
    const int xr = (r >> 1) & 7;
    int koff[4];
#pragma unroll
    for (int s = 0; s < 4; ++s) koff[s] = 16 * ((2 * s + hh) ^ xr);
    __syncthreads();
    AT_DMA(1, 0);
    if (tlast >= 2) AT_DMA(2, 1);
    if (tlast >= 3) AT_DMA(3, 2);
    if (tlast >= 3) asm volatile("s_waitcnt vmcnt(8) lgkmcnt(0)\n\ts_barrier" ::: "memory");
    else if (tlast == 2) asm volatile("s_waitcnt vmcnt(4) lgkmcnt(0)\n\ts_barrier" ::: "memory");
    else asm volatile("s_waitcnt vmcnt(0) lgkmcnt(0)\n\ts_barrier" ::: "memory");
#define AT_QK(SA, SB, t_) do { const LAS unsigned char* kb_ = F.lds + (((t_) - 1) & 3) * AT_STAGE + map * AT_KM + r * 128; \
        _Pragma("unroll") for (int i = 0; i < 16; ++i) { SA[i] = 0.f; SB[i] = 0.f; } \
        bf16x8 kf_[8]; _Pragma("unroll") for (int s = 0; s < 4; ++s) { kf_[2 * s] = *(const LAS bf16x8*)(kb_ + koff[s]); kf_[2 * s + 1] = *(const LAS bf16x8*)(kb_ + 32 * 128 + koff[s]); } \
        __builtin_amdgcn_sched_barrier(0); \
        _Pragma("unroll") for (int s = 0; s < 4; ++s) { SA = MFMA32(kf_[2 * s], qf[s], SA); SB = MFMA32(kf_[2 * s + 1], qf[s], SB); } \
        if (((t_) == 1) || (64 * (t_) + 63 > qw0)) { const int qp = qw0 + r, k0 = 64 * (t_) + 8 * hh; \
            _Pragma("unroll") for (int i = 0; i < 16; ++i) { const int kp = k0 + (i & 3) + 4 * ((i >> 2) & 1) + 16 * (i >> 3); if (kp > qp || kp < PADR) SA[i] = -1e30f; if (kp + 32 > qp || kp + 32 < PADR) SB[i] = -1e30f; } } } while (0)
    f32x16 S0, S1, N0, N1;
    AT_QK(S0, S1, 1);
    for (int t = 1; t <= tlast; ++t) {
        if (t < tlast) {
            if (t + 2 <= tlast) asm volatile("s_waitcnt vmcnt(4) lgkmcnt(0)\n\ts_barrier" ::: "memory");
            else asm volatile("s_waitcnt vmcnt(0) lgkmcnt(0)\n\ts_barrier" ::: "memory");
            if (t + 3 <= tlast) AT_DMA(t + 3, (t + 2) & 3);
            AT_QK(N0, N1, t + 1);
        }
        const LAS unsigned char* vbase = F.lds + ((t - 1) & 3) * AT_STAGE + AT_V + r * 128;
        float mx = max3f_(S0[0], S1[0], S0[1]), my = max3f_(S1[1], S0[2], S1[2]);
#pragma unroll
        for (int i = 3; i < 15; i += 2) { mx = max3f_(mx, S0[i], S1[i]); my = max3f_(my, S0[i + 1], S1[i + 1]); }
        mx = max3f_(mx, S0[15], S1[15]); mx = fmaxf(mx, my);
        { const auto sw = __builtin_amdgcn_permlane32_swap(__builtin_bit_cast(unsigned, mx), __builtin_bit_cast(unsigned, mx), false, false); mx = fmaxf(__builtin_bit_cast(float, sw[0]), __builtin_bit_cast(float, sw[1])); }
        if (!__all(mx <= mrun)) {
            const float mn = fmaxf(mrun, mx), alpha = __builtin_amdgcn_exp2f(mrun - mn);
            mrun = mn; lrun *= alpha;
#pragma unroll
            for (int d = 0; d < 4; ++d)
#pragma unroll
                for (int i = 0; i < 16; ++i) O[d][i] *= alpha;
        }
        f32x2_t ps2 = {0.f, 0.f};
#pragma unroll
        for (int i = 0; i < 16; ++i) { S0[i] = __builtin_amdgcn_exp2f(S0[i] - mrun); S1[i] = __builtin_amdgcn_exp2f(S1[i] - mrun); ps2 += (f32x2_t){S0[i], S1[i]}; }
        lrun += ps2.x + ps2.y;
#pragma unroll
        for (int s2 = 0; s2 < 2; ++s2) {
            v4u pw; pw.x = cvtpk_s(S0[8 * s2 + 0], S0[8 * s2 + 1]); pw.y = cvtpk_s(S0[8 * s2 + 2], S0[8 * s2 + 3]); pw.z = cvtpk_s(S0[8 * s2 + 4], S0[8 * s2 + 5]); pw.w = cvtpk_s(S0[8 * s2 + 6], S0[8 * s2 + 7]);
            const bf16x8 pf = __builtin_bit_cast(bf16x8, pw);
            bf16x8 vf[4];
#pragma unroll
            for (int d = 0; d < 4; ++d) vf[d] = *(const LAS bf16x8*)(vbase + d * 32 * 128 + koff[s2]);
#pragma unroll
            for (int d = 0; d < 4; ++d) O[d] = MFMA32(vf[d], pf, O[d]);
        }
#pragma unroll
        for (int s2 = 0; s2 < 2; ++s2) {
            v4u pw; pw.x = cvtpk_s(S1[8 * s2 + 0], S1[8 * s2 + 1]); pw.y = cvtpk_s(S1[8 * s2 + 2], S1[8 * s2 + 3]); pw.z = cvtpk_s(S1[8 * s2 + 4], S1[8 * s2 + 5]); pw.w = cvtpk_s(S1[8 * s2 + 6], S1[8 * s2 + 7]);
            const bf16x8 pf = __builtin_bit_cast(bf16x8, pw);
            bf16x8 vf[4];
#pragma unroll
            for (int d = 0; d < 4; ++d) vf[d] = *(const LAS bf16x8*)(vbase + d * 32 * 128 + koff[2 + s2]);
#pragma unroll
            for (int d = 0; d < 4; ++d) O[d] = MFMA32(vf[d], pf, O[d]);
        }
        if (t < tlast) { S0 = N0; S1 = N1; }
    }
#undef AT_QK
#undef AT_DMA
    __syncthreads();
    LAS unsigned char* lds = F.lds;
    lrun += __shfl_xor(lrun, 32);
    const float inv = 1.f / lrun;
    const float lam_init = 0.8f - 0.6f * __expf(-0.3f * (float)layer);
    float lam;
    { const float a1 = wave_sum(p.lq1[layer * 64 + lane] * p.lk1[layer * 64 + lane]), a2 = wave_sum(p.lq2[layer * 64 + lane] * p.lk2[layer * 64 + lane]);
      lam = __expf(a1) - __expf(a2) + lam_init; }
    LAS float* comb = (LAS float*)lds;
    if (map == 1) {
#pragma unroll
        for (int d = 0; d < 4; ++d)
#pragma unroll
            for (int i = 0; i < 16; ++i) comb[(qg * 128 + 32 * d + crow(i, hh)) * 32 + r] = O[d][i] * inv * lam;
    }
    __syncthreads();
    if (map == 0) {
        float ss = 0.f;
#pragma unroll
        for (int d = 0; d < 4; ++d)
#pragma unroll
            for (int i = 0; i < 16; ++i) { const float v = O[d][i] * inv - comb[(qg * 128 + 32 * d + crow(i, hh)) * 32 + r]; O[d][i] = v; ss += v * v; }
        ss += __shfl_xor(ss, 32);
        const float rs = rsqrtf(ss * (1.f / 128.f) + EPS) * (1.f - lam_init);
        const float* nw = p.diff_norm_w + layer * 128;
        if (qw0 + r >= PADR) {
            bf16* op = AQ + (rowb + qw0 + r) * 1024 + head * 128;
#pragma unroll
            for (int d = 0; d < 4; ++d)
#pragma unroll
                for (int g4 = 0; g4 < 4; ++g4) { const int dv = 32 * d + 8 * g4 + 4 * hh; const f32x4 wv = *(const f32x4*)(nw + dv);
                    v2u o; o.x = pk2(O[d][4 * g4 + 0] * rs * wv.x, O[d][4 * g4 + 1] * rs * wv.y); o.y = pk2(O[d][4 * g4 + 2] * rs * wv.z, O[d][4 * g4 + 3] * rs * wv.w);
                    *(v2u*)(op + dv) = o; }
        }
    }
    __syncthreads();
}

DI void ph_mixers(const Frame& F0, int layer) {
    constexpr int NDLA = 128, NU = NDLA + NB * 8 * 65;
    gu32* head = (gu32*)(F0.p.ws + WS_CTL) + CW_QUEUE + 64 * layer;
    volatile LAS unsigned* slot = (volatile LAS unsigned*)(F0.lds + MISC_OFF + 64);
    for (;;) {
        __syncthreads();
        if (threadIdx.x == 0) slot[0] = __hip_atomic_fetch_add(head, 1u, RLX_AGENT);
        __syncthreads();
        const int u = (int)__builtin_amdgcn_readfirstlane(slot[0]);
        if (u >= NU) break;
        Frame F = fresh(F0);
        if (u < 64) dla_unit<false>(F, u, layer);
        else if (u < NDLA) dla_unit<true>(F, u - 64, layer);
        else { const int a = u - NDLA, qb = 64 - a / 32, bh = a % 32; attn_unit(F, bh >> 3, bh & 7, qb, layer); }
    }
}

DI unsigned f2key(float x) { const unsigned u = __builtin_bit_cast(unsigned, x); return (u & 0x80000000u) ? ~u : (u | 0x80000000u); }
DI float key2f(unsigned k) { const unsigned u = (k & 0x80000000u) ? (k & 0x7fffffffu) : ~k; return __builtin_bit_cast(float, u); }
DI void kins16(unsigned (&t)[16], unsigned x) {
#pragma unroll
    for (int j = 0; j < 16; ++j) { const unsigned hi = x > t[j] ? x : t[j], lo = x > t[j] ? t[j] : x; t[j] = hi; x = lo; }
}
#define KCE(a, i, l) do { const unsigned hi_ = a[i] > a[l] ? a[i] : a[l], lo_ = a[i] > a[l] ? a[l] : a[i]; a[i] = hi_; a[l] = lo_; } while (0)
DI void ksort16(unsigned (&a)[16]) {
#pragma unroll
    for (int k = 2; k <= 16; k <<= 1)
#pragma unroll
        for (int j = k >> 1; j > 0; j >>= 1)
#pragma unroll
            for (int i = 0; i < 16; ++i) { const int l = i ^ j; if (l > i) { if ((i & k) == 0) KCE(a, i, l); else KCE(a, l, i); } }
}
DI void kmerge16(unsigned (&t)[16], const unsigned (&b)[16]) {
#pragma unroll
    for (int i = 0; i < 16; ++i) t[i] = t[i] > b[15 - i] ? t[i] : b[15 - i];
#pragma unroll
    for (int j = 8; j > 0; j >>= 1)
#pragma unroll
        for (int i = 0; i < 16; ++i) { const int l = i ^ j; if (l > i) KCE(t, i, l); }
}
DI void ktop16_of_128(const bf16* s, unsigned (&t)[16]) {
    for (int blk = 0; blk < 8; ++blk) {
        unsigned b[16];
#pragma unroll
        for (int j = 0; j < 2; ++j) { const v4u w_ = *(const v4u*)(s + 16 * blk + 8 * j); const unsigned k = 127u - (unsigned)(16 * blk + 8 * j);
            b[8 * j] = (f2key(bflo(w_.x)) & ~127u) | k; b[8 * j + 1] = (f2key(bfhi(w_.x)) & ~127u) | (k - 1); b[8 * j + 2] = (f2key(bflo(w_.y)) & ~127u) | (k - 2); b[8 * j + 3] = (f2key(bfhi(w_.y)) & ~127u) | (k - 3);
            b[8 * j + 4] = (f2key(bflo(w_.z)) & ~127u) | (k - 4); b[8 * j + 5] = (f2key(bfhi(w_.z)) & ~127u) | (k - 5); b[8 * j + 6] = (f2key(bflo(w_.w)) & ~127u) | (k - 6); b[8 * j + 7] = (f2key(bfhi(w_.w)) & ~127u) | (k - 7); }
        ksort16(b);
        if (blk == 0) {
#pragma unroll
            for (int j = 0; j < 16; ++j) t[j] = b[j];
        } else kmerge16(t, b);
    }
}
template <int I> DI void kcand_row(const float (&fa)[16], const float (&fb)[16], unsigned (&bt)[16]) {
    constexpr int NJ = 16 / (I + 1);
#pragma unroll
    for (int j = 0; j < NJ; ++j) kins16(bt, (f2key(fa[I] + fb[j]) & ~255u) | (unsigned)(255 - (I * 16 + j)));
}
DI void ph_topk(Frame& F) {
    const bf16* SC = (const bf16*)(F.ws + WS_SCORES); int* IDX = (int*)(F.ws + WS_IDX); float* GT = (float*)(F.ws + WS_GATE);
    const int gt = F.bid * 512 + F.tid, NT = F.G * 512;
    for (int it = gt; it < TP * 8; it += NT) {
        const int r = it >> 3, h = it & 7; const int b = r / TPB, q = r - b * TPB; if (q < PADR) continue;
        const bf16* s = SC + (size_t)r * 2048 + h * 256;
        unsigned ka[16], kb[16];
        ktop16_of_128(s, ka);
        ktop16_of_128(s + 128, kb);
        float fa[16], fb[16];
#pragma unroll
        for (int j = 0; j < 16; ++j) { fa[j] = key2f(ka[j] & ~127u); fb[j] = key2f(kb[j] & ~127u); }
        unsigned bt[16];
#pragma unroll
        for (int j = 0; j < 16; ++j) bt[j] = 0u;
        kcand_row<0>(fa, fb, bt); kcand_row<1>(fa, fb, bt); kcand_row<2>(fa, fb, bt); kcand_row<3>(fa, fb, bt);
        kcand_row<4>(fa, fb, bt); kcand_row<5>(fa, fb, bt); kcand_row<6>(fa, fb, bt); kcand_row<7>(fa, fb, bt);
        kcand_row<8>(fa, fb, bt); kcand_row<9>(fa, fb, bt); kcand_row<10>(fa, fb, bt); kcand_row<11>(fa, fb, bt);
        kcand_row<12>(fa, fb, bt); kcand_row<13>(fa, fb, bt); kcand_row<14>(fa, fb, bt); kcand_row<15>(fa, fb, bt);
        int eo[16]; float ge[16]; float sum = 0.f;
        const float s0 = key2f(bt[0] & ~255u);
#pragma unroll
        for (int k = 0; k < 16; ++k) {
            const int pos = 255 - (int)(bt[k] & 255u), pi = pos >> 4, pj = pos & 15; unsigned e0 = 0, e1 = 0;
#pragma unroll
            for (int j = 0; j < 16; ++j) { e0 = (pi == j) ? ka[j] : e0; e1 = (pj == j) ? kb[j] : e1; }
            eo[k] = (int)((127u - (e0 & 127u)) * 128u + (127u - (e1 & 127u))); ge[k] = __expf(key2f(bt[k] & ~255u) - s0); sum += ge[k];
        }
        const float inv = 1.f / sum;
        int* ip = IDX + (size_t)r * 128 + h * 16; float* gp = GT + (size_t)r * 128 + h * 16;
#pragma unroll
        for (int k = 0; k < 16; k += 4) { *(int4*)(ip + k) = make_int4(eo[k], eo[k + 1], eo[k + 2], eo[k + 3]); *(f32x4*)(gp + k) = (f32x4){ge[k] * inv, ge[k + 1] * inv, ge[k + 2] * inv, ge[k + 3] * inv}; }
    }
}

typedef float f32x2v __attribute__((ext_vector_type(2)));
DI float gelu_exact(float x) { return 0.5f * x * (1.f + erff(x * 0.70710678118654752f)); }
typedef int i32x8v __attribute__((ext_vector_type(8)));
typedef int i32x6v __attribute__((ext_vector_type(6)));
constexpr float PEER_HS = 8.f, PEER_LO = 32.f;
DI void ph_peer_u(Frame& F) {
    const Params& p = F.p;
    const bf16* U2 = (const bf16*)(F.ws + WS_U); const unsigned char* PU = (const unsigned char*)(F.ws + WS_PU);
    const int* IDX = (const int*)(F.ws + WS_IDX); const float* GT = (const float*)(F.ws + WS_GATE);
    const int lane = F.lane;
    const int part = F.bid & 7, np = (F.G - part + 7) >> 3, wi = (F.bid >> 3) * NWAVES + F.wave, nwp = np * NWAVES;
    const __amdgpu_buffer_rsrc_t pur = __builtin_amdgcn_make_buffer_rsrc((void*)PU, 0, 0x7fffffff, 0x00020000);
    LAS unsigned char* hl = F.lds + F.wave * 7168;
    LAS int* ce = (LAS int*)(hl + 6144); LAS int* cs = ce + 128;
    *(LAS v4u*)(hl + 4096 + 32 * lane) = (v4u){0u, 0u, 0u, 0u}; *(LAS v4u*)(hl + 4096 + 32 * lane + 16) = (v4u){0u, 0u, 0u, 0u};
    const LAS unsigned char *aLH, *aUH, *aLL, *aUL;
    { const int i = lane & 15, g = lane >> 4, G = i >> 2, ca = i & 3; const LAS unsigned char* hp = hl + 64 * ca + 16 * (g & 1); const LAS unsigned char* z = hl + 4096;
      const bool vl = G == (g >> 1), vu = G == 2 + (g >> 1);
      aLH = vl ? hp : z; aLL = vl ? hp + 2048 : z; aUH = vu ? hp : z; aUL = vu ? hp + 2048 : z; }
    int r = wi; while (r < TP && (r % TPB) < PADR) r += nwp;
    while (r < TP) {
        int ln = lane; asm volatile("" : "+v"(ln));
        const int b = r / TPB, q = r - b * TPB;
        const int i0 = IDX[(size_t)r * 128 + ln], i1 = IDX[(size_t)r * 128 + 64 + ln];
        {
            v4u hi[2], lo[2];
#pragma unroll
            for (int c = 0; c < 4; ++c) { const v4u t = *(const v4u*)(U2 + (size_t)r * DM + 32 * ln + 8 * c);
                const float f0 = bflo(t.x) * PEER_HS, f1 = bfhi(t.x) * PEER_HS, f2 = bflo(t.y) * PEER_HS, f3 = bfhi(t.y) * PEER_HS, f4 = bflo(t.z) * PEER_HS, f5 = bfhi(t.z) * PEER_HS, f6 = bflo(t.w) * PEER_HS, f7 = bfhi(t.w) * PEER_HS;
                const unsigned h0 = pk4f8(f0, f1, f2, f3), h1 = pk4f8(f4, f5, f6, f7);
                const f32x2v a0 = __builtin_amdgcn_cvt_pk_f32_fp8((int)h0, false), a1 = __builtin_amdgcn_cvt_pk_f32_fp8((int)h0, true), a2 = __builtin_amdgcn_cvt_pk_f32_fp8((int)h1, false), a3 = __builtin_amdgcn_cvt_pk_f32_fp8((int)h1, true);
                const unsigned l0 = pk4f8((f0 - a0.x) * PEER_LO, (f1 - a0.y) * PEER_LO, (f2 - a1.x) * PEER_LO, (f3 - a1.y) * PEER_LO), l1 = pk4f8((f4 - a2.x) * PEER_LO, (f5 - a2.y) * PEER_LO, (f6 - a3.x) * PEER_LO, (f7 - a3.y) * PEER_LO);
                hi[c >> 1][(c & 1) * 2] = h0; hi[c >> 1][(c & 1) * 2 + 1] = h1; lo[c >> 1][(c & 1) * 2] = l0; lo[c >> 1][(c & 1) * 2 + 1] = l1; }
            *(LAS v4u*)(hl + 32 * ln) = hi[0]; *(LAS v4u*)(hl + 32 * ln + 16) = hi[1]; *(LAS v4u*)(hl + 2048 + 32 * ln) = lo[0]; *(LAS v4u*)(hl + 2048 + 32 * ln + 16) = lo[1];
        }
        const bool m0 = (i0 & 7) == part, m1 = (i1 & 7) == part;
        const unsigned long long b0 = __ballot(m0), b1 = __ballot(m1);
        const int n0 = __popcll(b0), n = n0 + __popcll(b1);
        { const int p0 = __builtin_amdgcn_mbcnt_hi((unsigned)(b0 >> 32), __builtin_amdgcn_mbcnt_lo((unsigned)b0, 0u)), p1 = n0 + __builtin_amdgcn_mbcnt_hi((unsigned)(b1 >> 32), __builtin_amdgcn_mbcnt_lo((unsigned)b1, 0u));
          if (m0) { ce[p0] = i0; cs[p0] = ln; } if (m1) { ce[p1] = i1; cs[p1] = 64 + ln; } }
        const int cq = ln & 3;
        for (int blk = 0; 16 * blk < n; ++blk) {
            const int idx = 16 * blk + (ln >> 2); const bool valid = idx < n; const int idc = valid ? idx : n - 1;
            const int e = ce[idc];
            const unsigned off = (unsigned)e * 1536u + 48u * (unsigned)cq;
            v4u ub[8][3];
#pragma unroll
            for (int pp = 0; pp < 8; ++pp)
#pragma unroll
                for (int c = 0; c < 3; ++c) ub[pp][c] = __builtin_amdgcn_raw_buffer_load_b128(pur, off + 16 * c, 192 * pp, 0);
            f32x4 ach = (f32x4){0.f, 0.f, 0.f, 0.f}, acl = (f32x4){0.f, 0.f, 0.f, 0.f};
#define PU_A(lo_, up_, o) __builtin_shufflevector(__builtin_bit_cast(pg8::i32x4, *(const LAS v4u*)((lo_) + (o))), __builtin_bit_cast(pg8::i32x4, *(const LAS v4u*)((up_) + (o))), 0, 1, 2, 3, 4, 5, 6, 7)
#pragma unroll
            for (int pp = 0; pp < 8; ++pp)
#pragma unroll
                for (int t = 0; t < 2; ++t) { const i32x8v ah = PU_A(aLH, aUH, 256 * pp + 32 * t), al = PU_A(aLL, aUL, 256 * pp + 32 * t);
                    const i32x6v uf = t == 0 ? __builtin_shufflevector(__builtin_bit_cast(pg8::i32x4, ub[pp][0]), __builtin_bit_cast(pg8::i32x4, ub[pp][1]), 0, 1, 2, 3, 4, 5)
                                             : __builtin_shufflevector(__builtin_bit_cast(pg8::i32x4, ub[pp][1]), __builtin_bit_cast(pg8::i32x4, ub[pp][2]), 2, 3, 4, 5, 6, 7);
                    asm volatile("s_nop 1\n\tv_mfma_f32_16x16x128_f8f6f4 %0, %1, %2, %0 blgp:2" : "+v"(ach) : "v"(ah), "v"(uf));
                    asm volatile("v_mfma_f32_16x16x128_f8f6f4 %0, %1, %2, %0 blgp:2" : "+v"(acl) : "v"(al), "v"(uf)); }
#undef PU_A
            asm volatile("s_nop 7\n\ts_nop 7\n\ts_nop 7" : "+v"(ach), "+v"(acl));
            const f32x4 v = ach + acl * (1.f / PEER_LO);
            float d = cq == 0 ? v.x : cq == 1 ? v.y : cq == 2 ? v.z : v.w;
            d += __shfl_xor(d, 1); d += __shfl_xor(d, 2);
            if (valid && cq == 0) {
                const int slot = cs[idc]; const float g = GT[(size_t)r * 128 + slot];
                constexpr float DS = 1.f / (PEER_HS * PEER_USCALE);
                int* PK = (int*)(F.ws + WS_PK); const int di = b * (SEQ + META) + (q - PADR); int* pb = PK + ((size_t)(di >> 6) * 32 * 64 + (di & 63)) * 4;
                pb[(size_t)(slot >> 2) * 256 + (slot & 3)] = (e << 16) | (int)f2bf(g * gelu_exact(d * DS));
            }
        }
        r += nwp; while (r < TP && (r % TPB) < PADR) r += nwp;
    }
}
DI void ph_peer_v(Frame& F, int layer) {
    const Params& p = F.p;
    const int* PK = (const int*)(F.ws + WS_PK);
    LAS v2u* VL = (LAS v2u*)F.lds;
    constexpr int NREAL = NB * (SEQ + META);
    for (int s0 = F.bid; s0 < DM / 8; s0 += F.G) {
        const int sl = (s0 & 7) * 32 + (s0 >> 3);
        const int dcol = 8 * sl;
        { const v4u* src = (const v4u*)(F.ws + WS_PV) + (size_t)sl * (NEXP / 2);
#pragma unroll 4
          for (int i = F.tid; i < NEXP / 2; i += 512) ((LAS v4u*)VL)[i] = src[i]; }
        __syncthreads();
        for (int i = F.wave * 64 + F.lane; i < NREAL; i += 512) {
            const int b = i / (SEQ + META), q = i - b * (SEQ + META); const int r = b * TPB + PADR + q;
            const int4* ip = (const int4*)PK + (size_t)(i >> 6) * 32 * 64 + (i & 63);
            f32x2v y2[4];
#pragma unroll
            for (int j = 0; j < 4; ++j) y2[j] = (f32x2v){0.f, 0.f};
#define PV_ACC(pk) do { const v2u vv = VL[(unsigned)(pk) >> 16]; const float wt = __builtin_bit_cast(float, (unsigned)(pk) << 16); \
                    const f32x2v a0 = __builtin_amdgcn_cvt_pk_f32_fp8((int)vv.x, false), a1 = __builtin_amdgcn_cvt_pk_f32_fp8((int)vv.x, true), a2 = __builtin_amdgcn_cvt_pk_f32_fp8((int)vv.y, false), a3 = __builtin_amdgcn_cvt_pk_f32_fp8((int)vv.y, true); \
                    const f32x2v w2 = (f32x2v){wt, wt}; y2[0] = __builtin_elementwise_fma(a0, w2, y2[0]); y2[1] = __builtin_elementwise_fma(a1, w2, y2[1]); y2[2] = __builtin_elementwise_fma(a2, w2, y2[2]); y2[3] = __builtin_elementwise_fma(a3, w2, y2[3]); } while (0)
            int4 ea = ip[0], eb = ip[64], ec = ip[128], ed = ip[192];
            for (int k4 = 0; k4 < 32; k4 += 4) {
                const int4 ca = ea, cb = eb, cc = ec, cd = ed;
                if (k4 + 4 < 32) { ea = ip[64 * (k4 + 4)]; eb = ip[64 * (k4 + 5)]; ec = ip[64 * (k4 + 6)]; ed = ip[64 * (k4 + 7)]; }
                PV_ACC(ca.x); PV_ACC(ca.y); PV_ACC(ca.z); PV_ACC(ca.w); PV_ACC(cb.x); PV_ACC(cb.y); PV_ACC(cb.z); PV_ACC(cb.w);
                PV_ACC(cc.x); PV_ACC(cc.y); PV_ACC(cc.z); PV_ACC(cc.w); PV_ACC(cd.x); PV_ACC(cd.y); PV_ACC(cd.z); PV_ACC(cd.w);
            }
#undef PV_ACC
            bf16* yo = (bf16*)(F.ws + WS_Y) + (size_t)r * DM + dcol;
            const float isc = 1.f / PEER_VSCALE;
            *(v4u*)yo = (v4u){pk2(y2[0].x * isc, y2[0].y * isc), pk2(y2[1].x * isc, y2[1].y * isc), pk2(y2[2].x * isc, y2[2].y * isc), pk2(y2[3].x * isc, y2[3].y * isc)};
        }
        __syncthreads();
    }
}

constexpr int PH_PER_LAYER = 13, N_PHASES = 1 + DEPTH * PH_PER_LAYER + 1;

#define IN(k) (lo <= (k) && (k) < hi)
#define SEAM(k) do { if (IN(k) && IN((k) + 1)) xcd_barrier(bar); } while (0)

template <int LAYER>
DI void layer_phases(const Frame& F0, const XcdBarrier& bar, const int lo, const int hi) {
    constexpr int layer = LAYER, base = 1 + LAYER * PH_PER_LAYER;
    const Params& prm = F0.p;
    if (IN(base + 0)) { Frame F = fresh(F0); ph_weights(F, layer); __syncthreads(); ph_norm(F, prm.mix_norm_w + layer * DM, layer == 0, layer != 0, true); } SEAM(base + 0);
    if (IN(base + 1)) { Frame F = fresh(F0); unsigned char* ws = F.ws;
        pg8::Gemm g{(const bf16*)(ws + WS_U), (const bf16*)(ws + WS_WTA), TP, NA_COLS, DM, DM, DM, 0}; pg8::StaticOrder S; S.init(TP, NA_COLS, F.G, F.bid);
        EpiInA E{ws};
        pg8::gemm_phase<EpiInA, pg8::StaticOrder>(F.lds, g, S, E);
    } SEAM(base + 1);
    if (IN(base + 2)) {
        { Frame F = fresh(F0); ph_conv(F, layer); }
        { Frame F = fresh(F0); ph_rope_apply(F); }
        { Frame F = fresh(F0); ph_vtranspose(F); }
    } SEAM(base + 2);
    if (IN(base + 3)) { ph_mixers(F0, layer); } SEAM(base + 3);
    if (IN(base + 4)) {
        { Frame F = fresh(F0); ph_mlfinal(F, layer); }
        Frame F = fresh(F0); unsigned char* ws = F.ws;
        pg8::Gemm g{(const bf16*)(ws + WS_U8), (const bf16*)(ws + WS_WTG), TP, NG_COLS, DM, DM, DM, 0}; pg8::StaticOrder S; S.init(TP, NG_COLS, F.G, F.bid);
        EpiGates E{(unsigned char*)(ws + WS_GATES)};
        pg8::gemm_phase<EpiGates, pg8::StaticOrder, true>(F.lds, g, S, E);
    } SEAM(base + 4);
    if (IN(base + 5)) {
        { Frame F = fresh(F0); unsigned char* ws = F.ws; pg8::StaticOrder S; S.init(TP, DM, F.G, F.bid);
          pg8::Gemm g{(const bf16*)(ws + WS_Z), (const bf16*)(ws + WS_WTB), TP, DM, 1024, 1024, 1024, 0};
          EpiMerge<0> E{(const unsigned char*)(ws + WS_GATES), (bf16*)(ws + WS_U), (const float*)(ws + WS_RSTD)}; pg8::gemm_phase<EpiMerge<0>, pg8::StaticOrder>(F.lds, g, S, E); }
        asm volatile("s_waitcnt vmcnt(0)" ::: "memory"); __syncthreads();
        { Frame F = fresh(F0); unsigned char* ws = F.ws; pg8::StaticOrder S; S.init(TP, DM, F.G, F.bid);
          pg8::Gemm g{(const bf16*)(ws + WS_MO), (const bf16*)(ws + WS_WTB) + (size_t)DM * 1024, TP, DM, 1024, 1024, 1024, 0};
          EpiMerge<1> E{(const unsigned char*)(ws + WS_GATES), (bf16*)(ws + WS_U), nullptr}; pg8::gemm_phase<EpiMerge<1>, pg8::StaticOrder>(F.lds, g, S, E); }
        asm volatile("s_waitcnt vmcnt(0)" ::: "memory"); __syncthreads();
        { Frame F = fresh(F0); unsigned char* ws = F.ws; pg8::StaticOrder S; S.init(TP, DM, F.G, F.bid);
          pg8::Gemm g{(const bf16*)(ws + WS_AQ), (const bf16*)(ws + WS_WTB) + (size_t)2 * DM * 1024, TP, DM, 1024, 1024, 1024, 0};
          EpiMerge<2> E{(const unsigned char*)(ws + WS_GATES), (bf16*)(ws + WS_U), nullptr}; pg8::gemm_phase<EpiMerge<2>, pg8::StaticOrder>(F.lds, g, S, E); }
        { Frame F = fresh(F0); ph_tables_dyn(F, layer); }
    } SEAM(base + 5);
    if (IN(base + 6)) { Frame F = fresh(F0); unsigned char* ws = F.ws;
        pg8::Gemm g{(const bf16*)(ws + WS_U), (const bf16*)(ws + WS_WTO), TP, DM, DM, DM, DM, 0}; pg8::StaticOrder S; S.init(TP, DM, F.G, F.bid);
        EpiResid E{prm, ws}; pg8::gemm_phase<EpiResid, pg8::StaticOrder>(F.lds, g, S, E);
    } SEAM(base + 6);
    if (IN(base + 7)) { Frame F = fresh(F0); ph_norm(F, prm.ffn_norm_w + layer * DM, false); } SEAM(base + 7);
    if (IN(base + 8)) { Frame F = fresh(F0); unsigned char* ws = F.ws;
        pg8::Gemm g{(const bf16*)(ws + WS_U), (const bf16*)(ws + WS_WTQ), TP, DM, DM, DM, DM, 0}; pg8::StaticOrder S; S.init(TP, DM, F.G, F.bid);
        EpiBf16 E{(bf16*)(ws + WS_QP), DM}; pg8::gemm_phase<EpiBf16, pg8::StaticOrder>(F.lds, g, S, E);
    } SEAM(base + 8);
    if (IN(base + 9)) { Frame F = fresh(F0); unsigned char* ws = F.ws;
        pg8::Gemm g{(const bf16*)(ws + WS_QP), (const bf16*)(ws + WS_SKP), TP, DM, 256, DM, 256, 256}; pg8::StaticOrder S; S.init(TP, DM, F.G, F.bid);
        EpiBf16 E{(bf16*)(ws + WS_SCORES), DM}; pg8::gemm_phase<EpiBf16, pg8::StaticOrder>(F.lds, g, S, E);
    } SEAM(base + 9);
    if (IN(base + 10)) { Frame F = fresh(F0); ph_topk(F); } SEAM(base + 10);
    if (IN(base + 11)) { Frame F = fresh(F0); ph_peer_u(F); } SEAM(base + 11);
    if (IN(base + 12)) { Frame F = fresh(F0); ph_peer_v(F, layer); } SEAM(base + 12);
}

__global__ void __launch_bounds__(NWAVES * 64, 2) fwd_kernel(Params prm) {
    extern __shared__ __attribute__((aligned(16))) unsigned char lds_raw[];
    const int tid_ = threadIdx.x;
    Frame F0{(LAS unsigned char*)lds_raw, tid_, tid_ & 63, __builtin_amdgcn_readfirstlane(tid_ >> 6), (int)gridDim.x, (int)blockIdx.x, prm.ws, prm};
    volatile LAS unsigned* MISC = (volatile LAS unsigned*)(F0.lds + MISC_OFF);
    for (int u = tid_; u < (LDS_BYTES - LDSCTL_OFF) / 4; u += NWAVES * 64) ((LAS unsigned*)(F0.lds + LDSCTL_OFF))[u] = 0u;
    __syncthreads();
    const int lo = prm.ph_lo, hi = prm.ph_hi;
    const bool multi = (hi - lo) > 1;
    XcdBarrier bar; bar.bar = (unsigned*)(prm.ws + WS_CTL) + CW_BAR; bar.x = 0; bar.st = nullptr;
    if (multi) bar = xcd_barrier_post((unsigned*)(prm.ws + WS_CTL) + CW_BAR, MISC + 8);

    if (IN(0)) { Frame F = fresh(F0); ph_rope(F); } SEAM(0);
    layer_phases<0>(F0, bar, lo, hi);
    layer_phases<1>(F0, bar, lo, hi);
    if (IN(N_PHASES - 1)) { Frame F = fresh(F0); ph_final(F); }
}
#undef IN
#undef SEAM

extern "C" void kernel_launch(void* const* d_in, const int* in_sizes, int n_in, void* d_out, int out_size, void* d_ws, size_t ws_size, hipStream_t stream) {
    static int grid = 0;
    if (grid == 0) {
        if (n_in != 29 || ws_size < WS_END) { fprintf(stderr, "kernel_launch: unexpected inputs (n_in %d, ws %zu, need %zu)\n", n_in, ws_size, (size_t)WS_END); grid = -1; return; }
        int dev = 0, cus = 0, per_cu = 0;
        if (hipGetDevice(&dev) != hipSuccess || hipDeviceGetAttribute(&cus, hipDeviceAttributeMultiprocessorCount, dev) != hipSuccess) { grid = -1; return; }
        if (hipFuncSetAttribute((const void*)fwd_kernel, hipFuncAttributeMaxDynamicSharedMemorySize, LDS_BYTES) != hipSuccess) { fprintf(stderr, "kernel_launch: hipFuncSetAttribute failed\n"); grid = -1; return; }
        if (hipOccupancyMaxActiveBlocksPerMultiprocessor(&per_cu, (const void*)fwd_kernel, NWAVES * 64, LDS_BYTES) != hipSuccess || per_cu < 1) fprintf(stderr, "kernel_launch: occupancy query reports %d\n", per_cu);
        (void)hipGetLastError();
        grid = cus;
    }
    if (grid < 0) return;
    (void)hipMemsetAsync((char*)d_ws + WS_CTL, 0, CTL_ZERO_BYTES, stream);
    Params p{};
    p.x = (const float*)d_in[0]; p.positions = (const int*)d_in[1]; p.meta = (const float*)d_in[2]; p.mix_norm_w = (const float*)d_in[3]; p.w_in = (const float*)d_in[4];
    p.conv_w = (const float*)d_in[5]; p.conv_b = (const float*)d_in[6]; p.dt_bias = (const float*)d_in[7]; p.a_log = (const float*)d_in[8]; p.ssd_d = (const float*)d_in[9];
    p.ssd_norm_w = (const float*)d_in[10]; p.i_bias = (const float*)d_in[11]; p.f_bias = (const float*)d_in[12]; p.ml_norm_w = (const float*)d_in[13];
    p.lq1 = (const float*)d_in[14]; p.lk1 = (const float*)d_in[15]; p.lq2 = (const float*)d_in[16]; p.lk2 = (const float*)d_in[17]; p.diff_norm_w = (const float*)d_in[18];
    p.w_bs = (const float*)d_in[19]; p.w_bm = (const float*)d_in[20]; p.w_bd = (const float*)d_in[21]; p.w_out = (const float*)d_in[22]; p.ffn_norm_w = (const float*)d_in[23];
    p.peer_wq = (const float*)d_in[24]; p.sub_keys = (const float*)d_in[25]; p.peer_u = (const float*)d_in[26]; p.peer_v = (const float*)d_in[27]; p.final_norm_w = (const float*)d_in[28];
    p.out = (float*)d_out; p.ws = (unsigned char*)d_ws;
#if MK_N_LAUNCHES == 1
    p.ph_lo = 0; p.ph_hi = N_PHASES;
    hipLaunchKernelGGL(fwd_kernel, dim3(grid), dim3(NWAVES * 64), LDS_BYTES, stream, p);
#else
    for (int ph = 0; ph < N_PHASES; ++ph) { p.ph_lo = ph; p.ph_hi = ph + 1; hipLaunchKernelGGL(fwd_kernel, dim3(grid), dim3(NWAVES * 64), LDS_BYTES, stream, p); }
#endif
    const hipError_t le = hipPeekAtLastError();
    if (le != hipSuccess) fprintf(stderr, "kernel_launch: launch failed: %s\n", hipGetErrorName(le));
}
```
